# Optimizing an MI355X kernel written in HIP

```python
import math
import jax
import jax.numpy as jnp
from jax import lax
import numpy as np

D_MODEL = 1024
BATCH = 16
SEQ = 2048
DEPTH = 2

CTX_LEN = 256
GRID_W = 64
HEAD_DIM = 64
N_GROUPS = 4
GROUP_W = D_MODEL // N_GROUPS
MIX_W = N_GROUPS * GROUP_W
HEADS_PER_GROUP = GROUP_W // HEAD_DIM
CHUNK = 128
DIFF_D = HEAD_DIM // 2
NA_ROWS = 8
NA_COLS = 16
NA_QCOLS = 16
NA_KCOLS = 32
N_EXPERTS = 16
EXPERT_FF = D_MODEL
CAPACITY_FACTOR = 2
ROPE_BASE = 10000.0
EPS = 1e-6
DIFF_Q_BLOCK = 128
A_END = 2 * GROUP_W
B_END = A_END + GROUP_W
C_END = B_END + 3 * GROUP_W
IN_W = C_END + 3 * GROUP_W

kernel_name = "hybrid_diffusion_parallel_mixers_ec_moe"


def rms_norm(x, g=None, eps=EPS):
    xf = x.astype(jnp.float32)
    y = xf * lax.rsqrt(jnp.mean(xf * xf, axis=-1, keepdims=True) + eps)
    if g is not None:
        y = y * g.astype(jnp.float32)
    return y.astype(x.dtype)


def axial_rope_tables(n_tokens, dim):
    half = dim // 2
    inv = 1.0 / (ROPE_BASE ** (jnp.arange(0, half, 2, dtype=jnp.float32) / half))
    t = jnp.arange(n_tokens)
    row = (t // GRID_W).astype(jnp.float32)[:, None] * inv
    col = (t % GRID_W).astype(jnp.float32)[:, None] * inv
    return (jnp.cos(row), jnp.sin(row), jnp.cos(col), jnp.sin(col))


def _rotate(x, cos, sin):
    x1, x2 = jnp.split(x, 2, axis=-1)
    return jnp.concatenate([x1 * cos - x2 * sin, x2 * cos + x1 * sin], axis=-1)


def apply_axial_rope(x, rope):
    n = x.shape[1]
    shp = (1, n) + (1,) * (x.ndim - 3) + (-1,)
    cr, sr, cc, sc = [t.reshape(shp).astype(x.dtype) for t in rope]
    xr, xc = jnp.split(x, 2, axis=-1)
    return jnp.concatenate([_rotate(xr, cr, sr), _rotate(xc, cc, sc)], axis=-1)


def chunk_spatial_gating(p, w_s, b_s):
    bn, n, _ = p.shape
    z = jax.nn.gelu(p)
    u, v = jnp.split(z, 2, axis=-1)
    v = rms_norm(v.reshape(bn, n // CHUNK, CHUNK, HEADS_PER_GROUP, HEAD_DIM))
    sv = jnp.einsum('hpq,bnqhc->bnphc', w_s, v) + b_s.T[None, None, :, :, None]
    return u * sv.reshape(bn, n, GROUP_W)


def fourier_mix(p):
    bn, n, _ = p.shape
    z = p.astype(jnp.float32).reshape(bn, n, HEADS_PER_GROUP, HEAD_DIM)
    f = jnp.fft.fft2(z, axes=(1, 3), norm="ortho").real
    return f.reshape(bn, n, GROUP_W).astype(p.dtype)


def lambda_value(lam, lam_init):
    lf = lam.astype(jnp.float32)
    return jnp.exp(jnp.sum(lf[0] * lf[1])) - jnp.exp(jnp.sum(lf[2] * lf[3])) + lam_init


def diff_attn_core(q, k, v, lam):
    s = jnp.einsum('bqhmd,bkhmd->bhmqk', q, k).astype(jnp.float32) * (DIFF_D ** -0.5)
    a = jax.nn.softmax(s, axis=-1)
    w = a[:, :, 0] - lam * a[:, :, 1]
    return jnp.einsum('bhqk,bkhd->bqhd', w.astype(v.dtype), v)


def ctx_attention(q, k, v):
    s = jnp.einsum('bqhd,bkhd->bhqk', q, k).astype(jnp.float32) * (HEAD_DIM ** -0.5)
    p = jax.nn.softmax(s, axis=-1).astype(v.dtype)
    return jnp.einsum('bhqk,bkhd->bqhd', p, v)


def neighbourhood_attn_latent(q, k, v, kc, vc, rpb):
    bn, n, h, dh = q.shape
    rows = n // GRID_W
    kr = min(NA_ROWS, rows)
    n_cb = GRID_W // NA_QCOLS
    scale = HEAD_DIM ** -0.5
    qg = q.reshape(bn, rows, n_cb, NA_QCOLS, h, dh).transpose(1, 0, 2, 3, 4, 5)
    kg = k.reshape(bn, rows, GRID_W, h, dh)
    vg = v.reshape(bn, rows, GRID_W, h, dh)
    qcol = jnp.arange(GRID_W).reshape(n_cb, NA_QCOLS)
    kstart = jnp.clip(qcol[:, 0] - NA_COLS // 2, 0, GRID_W - NA_KCOLS)
    kcol = kstart[:, None] + jnp.arange(NA_KCOLS)
    wstart = jnp.clip(qcol - NA_COLS // 2, 0, GRID_W - NA_COLS)
    kc3 = kcol[:, None, :]
    valid = (kc3 >= wstart[..., None]) & (kc3 < wstart[..., None] + NA_COLS)
    coff = jnp.clip(kc3 - qcol[..., None], -(NA_COLS - 1), NA_COLS - 1) + NA_COLS - 1
    rpb_c = rpb[:, :, coff]
    n_loc = kr * NA_KCOLS

    def one_row(args):
        r, q_row = args
        rstart = jnp.clip(r - kr // 2, 0, rows - kr)
        k_rows = lax.dynamic_slice_in_dim(kg, rstart, kr, axis=1)
        v_rows = lax.dynamic_slice_in_dim(vg, rstart, kr, axis=1)
        k_blk = k_rows[:, :, kcol]
        v_blk = v_rows[:, :, kcol]
        roff = rstart + jnp.arange(kr) - r + NA_ROWS - 1
        bias = rpb_c[:, roff].transpose(0, 2, 3, 1, 4).astype(jnp.float32)
        s_loc = jnp.einsum('bjqhd,brjkhd->bhjqrk', q_row, k_blk).astype(jnp.float32) * scale + bias
        s_loc = jnp.where(valid[:, :, None, :], s_loc, -jnp.inf)
        s_loc = s_loc.reshape(bn, h, n_cb, NA_QCOLS, n_loc)
        s_ctx = jnp.einsum('bjqhd,bkhd->bhjqk', q_row, kc).astype(jnp.float32) * scale
        p = jax.nn.softmax(jnp.concatenate([s_loc, s_ctx], axis=-1), axis=-1).astype(v.dtype)
        p_loc = p[..., :n_loc].reshape(bn, h, n_cb, NA_QCOLS, kr, NA_KCOLS)
        p_ctx = p[..., n_loc:]
        o = (jnp.einsum('bhjqrk,brjkhd->bjqhd', p_loc, v_blk)
             + jnp.einsum('bhjqk,bkhd->bjqhd', p_ctx, vc))
        return o.reshape(bn, GRID_W, h * dh)

    out = lax.map(one_row, (jnp.arange(rows), qg))
    return out.transpose(1, 0, 2, 3).reshape(bn, n, h * dh)


def token_mixers(hx, hc, w_in, w_out, head_g, sgu_w, sgu_b, dqn, dkn, dlam,
                 nqn, nkn, rpb, rope, lam_init, ctx_out):
    bn, n, _ = hx.shape
    h = HEADS_PER_GROUP
    px = hx @ w_in
    pc = hc @ w_in
    lam = lambda_value(dlam, lam_init)
    head_scale = jnp.asarray(np.array([1.0] * (2 * h) + [1.0 - lam_init] * h + [1.0] * h,
                                      dtype=np.float32), dtype=hx.dtype)

    def groups(p):
        return p[..., :A_END], p[..., A_END:B_END], p[..., B_END:C_END], p[..., C_END:]

    def diff_qkv(p, use_rope):
        m = p.shape[1]
        q, k, v = jnp.split(p, 3, axis=-1)
        q = rms_norm(q.reshape(bn, m, h, 2, DIFF_D), dqn)
        k = rms_norm(k.reshape(bn, m, h, 2, DIFF_D), dkn)
        if use_rope:
            q = apply_axial_rope(q, rope)
            k = apply_axial_rope(k, rope)
        return q, k, v.reshape(bn, m, h, HEAD_DIM)

    def na_qkv(p):
        m = p.shape[1]
        q, k, v = jnp.split(p, 3, axis=-1)
        q = rms_norm(q.reshape(bn, m, h, HEAD_DIM), nqn)
        k = rms_norm(k.reshape(bn, m, h, HEAD_DIM), nkn)
        return q, k, v.reshape(bn, m, h, HEAD_DIM)

    def merge(ya, yb, yc, yd):
        y = jnp.concatenate([ya, yb, yc, yd], axis=-1)
        m = y.shape[1]
        y = rms_norm(y.reshape(bn, m, N_GROUPS * h, HEAD_DIM), head_g.reshape(N_GROUPS * h, HEAD_DIM))
        y = y * head_scale[:, None]
        return y.reshape(bn, m, MIX_W) @ w_out

    aX, bX, cX, dX = groups(px)
    aC, bC, cC, dC = groups(pc)

    cq_c, ck_c, cv_c = diff_qkv(cC, False)
    nq_c, nk_c, nv_c = na_qkv(dC)

    ya = chunk_spatial_gating(aX, sgu_w, sgu_b)
    yb = fourier_mix(bX)
    cq, ck, cv = diff_qkv(cX, True)
    k_all = jnp.concatenate([ck, ck_c], axis=1)
    v_all = jnp.concatenate([cv, cv_c], axis=1)
    qb = cq.reshape(bn, n // DIFF_Q_BLOCK, DIFF_Q_BLOCK, h, 2, DIFF_D).transpose(1, 0, 2, 3, 4, 5)
    yc = lax.map(lambda qblk: diff_attn_core(qblk, k_all, v_all, lam), qb)
    yc = yc.transpose(1, 0, 2, 3, 4).reshape(bn, n, GROUP_W)
    nq, nk, nv = na_qkv(dX)
    yd = neighbourhood_attn_latent(nq, nk, nv, nk_c, nv_c, rpb)
    y_lat = merge(ya, yb, yc, yd)

    if not ctx_out:
        return y_lat, None
    m = hc.shape[1]
    ya_c = chunk_spatial_gating(aC, sgu_w, sgu_b)
    yb_c = fourier_mix(bC)
    yc_c = diff_attn_core(cq_c, ck_c, cv_c, lam).reshape(bn, m, GROUP_W)
    yd_c = ctx_attention(nq_c, nk_c, nv_c).reshape(bn, m, GROUP_W)
    return y_lat, merge(ya_c, yb_c, yc_c, yd_c)


def expert_choice_ffn(x, router_w, wg, wu, wd):
    bn, n, _ = x.shape
    cap = CAPACITY_FACTOR * n // N_EXPERTS
    aff = jax.nn.softmax(jnp.einsum('bnd,de->bne', x, router_w).astype(jnp.float32), axis=-1)
    gate, idx = lax.top_k(aff.transpose(0, 2, 1), cap)
    bidx = jnp.arange(bn)[:, None, None]
    xg = x[bidx, idx]
    hid = jax.nn.silu(jnp.einsum('becd,edf->becf', xg, wg)) * jnp.einsum('becd,edf->becf', xg, wu)
    o = jnp.einsum('becf,efd->becd', hid, wd) * gate[..., None].astype(x.dtype)
    return jnp.zeros_like(x).at[bidx, idx].add(o)


def setup_inputs(seed: int = 0) -> dict:
    key = jax.random.key(seed)
    ks = jax.random.split(key, 24)
    f32 = jnp.float32
    L, D, H = DEPTH, D_MODEL, HEADS_PER_GROUP

    def nrm(k, shape, s):
        return jax.random.normal(k, shape, f32) * s

    return {
        "x": nrm(ks[0], (BATCH, SEQ, D), 1.0),
        "c": nrm(ks[1], (BATCH, D), 1.0),
        "ctx": nrm(ks[2], (BATCH, CTX_LEN, D), 1.0),
        "c_ctx": nrm(ks[3], (D,), 1.0),
        "ada_w": nrm(ks[4], (L, D, 6 * D), 0.5 * D ** -0.5),
        "ada_b": nrm(ks[5], (L, 6 * D), 0.02),
        "norm1_g": 1.0 + nrm(ks[6], (L, D), 0.02),
        "norm2_g": 1.0 + nrm(ks[7], (L, D), 0.02),
        "w_in": nrm(ks[8], (L, D, IN_W), D ** -0.5),
        "w_out": nrm(ks[9], (L, MIX_W, D), MIX_W ** -0.5),
        "head_out_g": 1.0 + nrm(ks[10], (L, MIX_W), 0.02),
        "sgu_w": nrm(ks[11], (L, H, CHUNK, CHUNK), CHUNK ** -0.5),
        "sgu_b": 1.0 + nrm(ks[12], (L, H, CHUNK), 0.02),
        "diff_qn_g": 1.0 + nrm(ks[13], (L, DIFF_D), 0.02),
        "diff_kn_g": 1.0 + nrm(ks[14], (L, DIFF_D), 0.02),
        "diff_lambda": nrm(ks[15], (L, 4, DIFF_D), 0.1),
        "na_qn_g": 1.0 + nrm(ks[16], (L, HEAD_DIM), 0.02),
        "na_kn_g": 1.0 + nrm(ks[17], (L, HEAD_DIM), 0.02),
        "na_rpb": nrm(ks[18], (L, H, 2 * NA_ROWS - 1, 2 * NA_COLS - 1), 0.1),
        "router_w": nrm(ks[19], (L, D, N_EXPERTS), D ** -0.5),
        "exp_w_gate": nrm(ks[20], (L, N_EXPERTS, D, EXPERT_FF), D ** -0.5),
        "exp_w_up": nrm(ks[21], (L, N_EXPERTS, D, EXPERT_FF), D ** -0.5),
        "exp_w_down": nrm(ks[22], (L, N_EXPERTS, EXPERT_FF, D), EXPERT_FF ** -0.5),
    }


def reference(x, c, ctx, c_ctx, ada_w, ada_b, norm1_g, norm2_g, w_in, w_out, head_out_g,
              sgu_w, sgu_b, diff_qn_g, diff_kn_g, diff_lambda, na_qn_g, na_kn_g, na_rpb,
              router_w, exp_w_gate, exp_w_up, exp_w_down):
    n = x.shape[1]
    rope = axial_rope_tables(n, DIFF_D)
    s_c = jax.nn.silu(c)
    s_cc = jax.nn.silu(c_ctx)
    xc = ctx
    for l in range(DEPTH):
        last = l == DEPTH - 1
        lam_init = 0.8 - 0.6 * math.exp(-0.3 * l)
        mod = (s_c @ ada_w[l] + ada_b[l])[:, None, :]
        mod_c = (s_cc @ ada_w[l] + ada_b[l])[None, None, :]
        sh1, sc1, g1, sh2, sc2, g2 = jnp.split(mod, 6, axis=-1)
        csh1, csc1, cg1, csh2, csc2, cg2 = jnp.split(mod_c, 6, axis=-1)
        hx = rms_norm(x, norm1_g[l]) * (1.0 + sc1) + sh1
        hc = rms_norm(xc, norm1_g[l]) * (1.0 + csc1) + csh1
        y_lat, y_ctx = token_mixers(hx, hc, w_in[l], w_out[l], head_out_g[l], sgu_w[l], sgu_b[l],
                                    diff_qn_g[l], diff_kn_g[l], diff_lambda[l],
                                    na_qn_g[l], na_kn_g[l], na_rpb[l], rope, lam_init,
                                    not last)
        x = x + g1 * y_lat
        x = x + g2 * expert_choice_ffn(rms_norm(x, norm2_g[l]) * (1.0 + sc2) + sh2,
                                       router_w[l], exp_w_gate[l], exp_w_up[l], exp_w_down[l])
        if not last:
            xc = xc + cg1 * y_ctx
            xc = xc + cg2 * expert_choice_ffn(rms_norm(xc, norm2_g[l]) * (1.0 + csc2) + csh2,
                                              router_w[l], exp_w_gate[l], exp_w_up[l], exp_w_down[l])
    return x
```

```cpp
#include <hip/hip_runtime.h>
#include <stdint.h>
#include <cstdio>

#ifndef MK_ONE_LAUNCH
#define MK_ONE_LAUNCH 1
#endif

#ifndef REP_MIX
#define REP_MIX 0
#endif
#ifndef REP_MASK
#define REP_MASK 0
#endif
#define LAS __attribute__((address_space(3)))
typedef unsigned short bf16_t;
typedef float f32x4 __attribute__((ext_vector_type(4)));
typedef short bf16x8 __attribute__((ext_vector_type(8)));
typedef unsigned u32x2 __attribute__((ext_vector_type(2)));
typedef unsigned u32x4 __attribute__((ext_vector_type(4)));

constexpr int D = 1024, NB = 16, SEQ = 2048, CTXL = 256;
constexpr int NLAT = NB * SEQ, NCTX = NB * CTXL, NROW = NLAT + NCTX;
constexpr int INW = 2560;
constexpr int C_AU = 0, C_AV = 256, C_ZC = 512, C_ZS = 768, C_CQ = 1024, C_CK = 1280, C_CV = 1536, C_DQ = 1792, C_DK = 2048, C_DV = 2304;
constexpr int NE = 16, CAPL = 256, CAPC = 32, MEST = NB * CAPL + NB * CAPC;
constexpr int NT = 512;
constexpr float EPS = 1e-6f;
constexpr int LDS_BYTES = 147456;
constexpr int LDS_EXTRA = 131072;

constexpr size_t MiB = 1u << 20;
constexpr size_t WS_CTL = 0, CTL_BYTES = 1 * MiB;
constexpr size_t WS_MOD = 1 * MiB;
constexpr size_t WS_ROPE = 2 * MiB;
constexpr size_t WS_CONST = 2 * MiB + 512 * 1024;
constexpr size_t WS_WIN = 3 * MiB;
constexpr size_t WS_WOUT = 13 * MiB;
constexpr size_t WS_DFT2 = 17 * MiB;
constexpr size_t WS_DFTC2 = 2 * MiB + 640 * 1024;
constexpr size_t WS_WGU = 33 * MiB;
constexpr size_t WS_WD = 97 * MiB;
constexpr size_t WS_XC = 129 * MiB;
constexpr size_t WS_AFF = 145 * MiB;
constexpr size_t WS_IDX = 148 * MiB;
constexpr size_t WS_GATE = 148 * MiB + 512 * 1024;
constexpr size_t WS_INV = 149 * MiB;
constexpr size_t WS_ZT = 152 * MiB;
constexpr size_t WS_VT = 188 * MiB;
constexpr size_t WS_VTD = 206 * MiB;
constexpr size_t WS_S2 = 224 * MiB;
constexpr size_t WS_S1 = 368 * MiB;
constexpr size_t WS_END = 548 * MiB;
constexpr size_t VT_CTX_OFF = (size_t)NB * 256 * 2048;
constexpr size_t HN8_OFF = (size_t)NROW * 1024 * 2;
constexpr float W8_SCALE = 32.f, HID8_SCALE = 4.f;
constexpr size_t XG8_OFF = (size_t)NE * MEST * 1024;

struct Params {
    const float *x, *c, *ctx, *c_ctx, *ada_w, *ada_b, *norm1_g, *norm2_g, *w_in, *w_out, *head_g, *sgu_w, *sgu_b,
                *dqn, *dkn, *dlam, *nqn, *nkn, *rpb, *router_w, *wg, *wu, *wd;
    float* out; unsigned char* ws;
    int ph_lo, ph_hi;
};

typedef float hwf32x2_t __attribute__((ext_vector_type(2)));
typedef __bf16 hwbf16x2_t __attribute__((ext_vector_type(2)));
__device__ __forceinline__ unsigned pk2(float lo, float hi) { const hwf32x2_t v = {lo, hi}; return __builtin_bit_cast(unsigned, __builtin_convertvector(v, hwbf16x2_t)); }
__device__ __forceinline__ unsigned f2bf(float f) { return pk2(f, 0.f) & 0xffffu; }
__device__ __forceinline__ float bf2f(unsigned h) { return __uint_as_float(h << 16); }
__device__ __forceinline__ float bflo(unsigned w) { return __uint_as_float(w << 16); }
__device__ __forceinline__ float bfhi(unsigned w) { return __uint_as_float(w & 0xffff0000u); }
__device__ __forceinline__ float wave_sum(float v) {
#pragma unroll
    for (int o = 1; o < 64; o <<= 1) v += __shfl_xor(v, o);
    return v;
}
__device__ __forceinline__ int otid() { int t = threadIdx.x; asm volatile("" : "+v"(t)); return t; }
__device__ __forceinline__ float gelu_tanh(float x) {
    const float y2 = -2.302208198f * (x + 0.044715f * x * x * x);
    return x * __builtin_amdgcn_rcpf(1.f + __builtin_amdgcn_exp2f(y2));
}
__device__ __forceinline__ float silu_f(float v) { return v / (1.f + expf(-v)); }
__device__ __forceinline__ float silu_fast(float v) { return v * __builtin_amdgcn_rcpf(1.f + __builtin_amdgcn_exp2f(-1.4426950408889634f * v)); }

__device__ __forceinline__ const float* xrow(const Params& p, int l, int r) {
    if (l == 0) return r < NLAT ? p.x + (size_t)r * D : p.ctx + (size_t)(r - NLAT) * D;
    return r < NLAT ? p.out + (size_t)r * D : (const float*)(p.ws + WS_XC) + (size_t)(r - NLAT) * D;
}
__device__ __forceinline__ float* xlrow(const Params& p, int r) {
    return r < NLAT ? p.out + (size_t)r * D : (float*)(p.ws + WS_XC) + (size_t)(r - NLAT) * D;
}

template <bool XBF> struct XRaw { u32x4 q[XBF ? 2 : 4]; };
template <bool XBF> __device__ __forceinline__ void xraw_load(XRaw<XBF>& d, const void* lat, const void* ctx, int r, int lane) {
    if constexpr (XBF) { const bf16_t* s = (r < NLAT ? (const bf16_t*)lat + (size_t)r * D : (const bf16_t*)ctx + (size_t)(r - NLAT) * D) + lane * 4;
        const u32x2 a = *(const u32x2*)s, b = *(const u32x2*)(s + 256), c = *(const u32x2*)(s + 512), e = *(const u32x2*)(s + 768);
        d.q[0] = (u32x4){a.x, a.y, b.x, b.y}; d.q[1] = (u32x4){c.x, c.y, e.x, e.y}; }
    else { const float* s = (r < NLAT ? (const float*)lat + (size_t)r * D : (const float*)ctx + (size_t)(r - NLAT) * D) + lane * 4;
#pragma unroll
        for (int i = 0; i < 4; ++i) d.q[i] = *(const u32x4*)(s + i * 256); }
}
template <bool XBF> __device__ __forceinline__ void xraw_get(const XRaw<XBF>& d, f32x4 (&v)[4]) {
    if constexpr (XBF) { v[0] = (f32x4){bflo(d.q[0].x), bfhi(d.q[0].x), bflo(d.q[0].y), bfhi(d.q[0].y)}; v[1] = (f32x4){bflo(d.q[0].z), bfhi(d.q[0].z), bflo(d.q[0].w), bfhi(d.q[0].w)};
                         v[2] = (f32x4){bflo(d.q[1].x), bfhi(d.q[1].x), bflo(d.q[1].y), bfhi(d.q[1].y)}; v[3] = (f32x4){bflo(d.q[1].z), bfhi(d.q[1].z), bflo(d.q[1].w), bfhi(d.q[1].w)}; }
    else {
#pragma unroll
        for (int i = 0; i < 4; ++i) v[i] = __builtin_bit_cast(f32x4, d.q[i]); }
}

#define XB_TMO      128
#define XB_XCNT(j)  (256  + 64 * (j))
#define XB_XSUB(j)  (1280 + 64 * (j))
#define XB_XGEN(j)  (2304 + 64 * (j))
#define XB_TOP      3328
#define XB_TOPGEN   3392
#define XCD_BAR_WORDS 3456
#define XB_SPIN_CAP (1u << 20)
__device__ __forceinline__ unsigned xb_ld(unsigned* p)              { return __hip_atomic_load(p, __ATOMIC_RELAXED, __HIP_MEMORY_SCOPE_AGENT); }
__device__ __forceinline__ unsigned xb_add(unsigned* p, unsigned v) { return __hip_atomic_fetch_add(p, v, __ATOMIC_RELAXED, __HIP_MEMORY_SCOPE_AGENT); }
__device__ __forceinline__ unsigned xb_xcc_id() { return (unsigned)__builtin_amdgcn_s_getreg((3 << 11) | 20) & 0xFu; }
#define XB_SPIN(cond, bar) do { unsigned _sp = 0; while (cond) { __builtin_amdgcn_s_sleep(1); \
    if ((++_sp & 255u) == 0u) { if (xb_ld(&(bar)[XB_TMO])) break; if (_sp > XB_SPIN_CAP) { atomicAdd(&(bar)[XB_TMO], 1u); break; } } } } while (0)
struct XcdBarrier { unsigned* bar; unsigned x; volatile LAS unsigned* st; };
__device__ __forceinline__ XcdBarrier xcd_barrier_post(unsigned* bar, volatile LAS unsigned* st) {
    XcdBarrier b; b.bar = bar; b.x = xb_xcc_id(); b.st = st;
    if (threadIdx.x == 0) (void)xb_add(&bar[XB_XCNT(b.x)], 1u);
    return b;
}
__device__ __forceinline__ void xcd_barrier_complete(unsigned* bar, unsigned x, unsigned& nloc, unsigned& nx) {
    const unsigned G = gridDim.x * gridDim.y * gridDim.z;
    unsigned sum, cnt, mine, sp = 0u;
    for (;;) {
        sum = 0u; cnt = 0u; mine = 0u;
#pragma unroll
        for (unsigned j = 0; j < 16; ++j) { const unsigned c = xb_ld(&bar[XB_XCNT(j)]); sum += c; cnt += (c > 0u) ? 1u : 0u; mine = (j == x) ? c : mine; }
        if (sum == G) break;
        __builtin_amdgcn_s_sleep(1);
        if ((++sp & 255u) == 0u) { if (xb_ld(&bar[XB_TMO])) break; if (sp > XB_SPIN_CAP) { atomicAdd(&bar[XB_TMO], 1u); break; } }
    }
    nloc = mine > 0u ? mine : 1u; nx = cnt > 0u ? cnt : 1u;
}
__device__ __forceinline__ void xcd_barrier(const XcdBarrier& b) {
    asm volatile("s_waitcnt vmcnt(0)" ::: "memory");
    __syncthreads();
    if (threadIdx.x == 0) {
        unsigned* bar = b.bar;
        __builtin_amdgcn_s_waitcnt(0);
        unsigned nloc = b.st[0], nx = b.st[1];
        if (nloc == 0u) { xcd_barrier_complete(bar, b.x, nloc, nx); b.st[0] = nloc; b.st[1] = nx; }
        const unsigned old = xb_add(&bar[XB_XSUB(b.x)], 1u);
        const unsigned gen = old / nloc;
        if (old + 1u == (gen + 1u) * nloc) {
            __builtin_amdgcn_fence(__ATOMIC_RELEASE, "agent");
            asm volatile("s_waitcnt vmcnt(0)" ::: "memory");
            const unsigned og = xb_add(&bar[XB_TOP], 1u);
            const unsigned tg = og / nx;
            if (og + 1u == (tg + 1u) * nx) xb_add(&bar[XB_TOPGEN], 1u);
            else XB_SPIN(xb_ld(&bar[XB_TOPGEN]) == tg, bar);
            __builtin_amdgcn_fence(__ATOMIC_ACQUIRE, "agent");
            xb_add(&bar[XB_XGEN(b.x)], 1u);
            asm volatile("s_waitcnt vmcnt(0)" ::: "memory");
        } else {
            XB_SPIN(xb_ld(&bar[XB_XGEN(b.x)]) == gen, bar);
            __builtin_amdgcn_fence(__ATOMIC_ACQUIRE, "agent");
            asm volatile("s_waitcnt vmcnt(0)" ::: "memory");
        }
    }
    __syncthreads();
}

struct TrJob { const float* src; size_t ld_src; bf16_t* dst; size_t ld_dst; int mode, offA, offB; };
__device__ __forceinline__ void tr_load(const TrJob& j, f32x4 (&v)[2]) {
    const int t = otid();
#pragma unroll
    for (int i = 0; i < 2; ++i) {
        const int k = (t >> 4) + 32 * i, n = (t & 15) * 4;
        v[i] = *(const f32x4*)(j.src + (size_t)k * j.ld_src + (n < 32 ? j.offA : j.offB) + (n & 31));
    }
}
__device__ __forceinline__ void tr_lds_in(const f32x4 (&v)[2], LAS float* sm) {
    const int t = otid();
    LAS float* tab = sm + 64 * 65;
    if (t < 64) { const float a = (float)t * (1.f / 64.f); tab[t] = __builtin_amdgcn_cosf(a); tab[64 + t] = __builtin_amdgcn_sinf(a); }
#pragma unroll
    for (int i = 0; i < 2; ++i) {
        const int k = (t >> 4) + 32 * i, n = (t & 15) * 4;
        sm[k * 65 + n + 0] = v[i][0]; sm[k * 65 + n + 1] = v[i][1]; sm[k * 65 + n + 2] = v[i][2]; sm[k * 65 + n + 3] = v[i][3];
    }
}
__device__ __forceinline__ void tr_lds_out(const TrJob& j, LAS float* sm) {
    const int t = otid();
    LAS float* tab = sm + 64 * 65;
    const int n = t >> 3, k0 = (t & 7) * 8;
    float o[8];
    if (j.mode == 0) {
#pragma unroll
        for (int i = 0; i < 8; ++i) o[i] = sm[(k0 + i) * 65 + n];
    } else {
        LAS float* tb = tab + (j.mode == 2 ? 64 : 0);
#pragma unroll
        for (int i = 0; i < 8; ++i) o[i] = 0.f;
        for (int cp = 0; cp < 64; ++cp) {
            const float w = tb[(cp * n) & 63];
#pragma unroll
            for (int i = 0; i < 8; ++i) o[i] += sm[(k0 + i) * 65 + cp] * w;
        }
    }
    u32x4 w; w.x = pk2(o[0], o[1]); w.y = pk2(o[2], o[3]); w.z = pk2(o[4], o[5]); w.w = pk2(o[6], o[7]);
    *(u32x4*)(j.dst + (size_t)n * j.ld_dst + k0) = w;
}
template <class Getter>
__device__ __forceinline__ void tr_stream(int njobs, const Getter& get, LAS float* sm) {
    int u = blockIdx.x;
    if (u >= njobs) return;
    TrJob cur = get(u), nxt = cur; f32x4 v[2], vn[2];
    tr_load(cur, v);
    for (; u < njobs; u += gridDim.x) {
        const int un = u + gridDim.x;
        tr_lds_in(v, sm);
        __syncthreads();
        if (un < njobs) { nxt = get(un); tr_load(nxt, vn); }
        tr_lds_out(cur, sm);
        __syncthreads();
        cur = nxt; v[0] = vn[0]; v[1] = vn[1];
    }
}

__device__ __forceinline__ void phase_prep(const Params& p, LAS char* smem) {
    const int tid = otid(), lane = tid & 63, wave = tid >> 6;
    float* MOD = (float*)(p.ws + WS_MOD);
    for (int u = blockIdx.x; u < 192; u += gridDim.x) {
        const int l = u / 96, c0 = (u % 96) * 64;
        LAS float* s = (LAS float*)smem;
        LAS float* red = s + 17 * 1024;
        for (int i = tid; i < 17 * 1024; i += NT) { const float v = (i < 16 * 1024) ? p.c[i] : p.c_ctx[i - 16 * 1024]; s[i] = silu_f(v); }
        __syncthreads();
        float acc[17];
#pragma unroll
        for (int bi = 0; bi < 17; ++bi) acc[bi] = 0.f;
        const float* W = p.ada_w + (size_t)l * 1024 * 6144 + c0 + lane;
        for (int k = wave; k < 1024; k += 256) {
            float a[32];
#pragma unroll
            for (int j = 0; j < 32; ++j) a[j] = W[(size_t)(k + 8 * j) * 6144];
#pragma unroll
            for (int j = 0; j < 32; ++j)
#pragma unroll
                for (int bi = 0; bi < 17; ++bi) acc[bi] += s[bi * 1024 + k + 8 * j] * a[j];
        }
#pragma unroll
        for (int bi = 0; bi < 17; ++bi) red[(wave * 17 + bi) * 64 + lane] = acc[bi];
        __syncthreads();
        for (int i = tid; i < 17 * 64; i += NT) {
            const int bi = i >> 6, cc = i & 63; float sum = 0.f;
#pragma unroll
            for (int w = 0; w < 8; ++w) sum += red[(w * 17 + bi) * 64 + cc];
            MOD[(size_t)(l * 17 + bi) * 6144 + c0 + cc] = sum + p.ada_b[l * 6144 + c0 + cc];
        }
        __syncthreads();
    }
    {
        float* ROPE = (float*)(p.ws + WS_ROPE);
        for (int u = blockIdx.x; u < 64; u += gridDim.x) {
            const int idx = u * NT + tid, n = idx >> 4, which = (idx >> 3) & 1, j = idx & 7;
            const float inv = 1.0f / powf(10000.f, (float)(2 * j) / 16.f);
            const float pos = which ? (float)(n & 63) : (float)(n >> 6);
            const float ang = pos * inv;
            ROPE[n * 32 + which * 16 + j] = cosf(ang); ROPE[n * 32 + which * 16 + 8 + j] = sinf(ang);
        }
    }
    {
        bf16_t* WIN = (bf16_t*)(p.ws + WS_WIN); const float* w_in = p.w_in;
        tr_stream(1280, [&](int u) {
            const int l = u / 640, rem = u % 640, nt = rem >> 4, kt = rem & 15, n0 = nt * 64, k0 = kt * 64;
            int mode = 0, sc = n0, offA = 0, offB = 32;
            if (n0 >= 512 && n0 < 768) { mode = 1; sc = n0; }
            else if (n0 >= 768 && n0 < 1024) { mode = 2; sc = n0 - 256; }
            else if (n0 >= 1024) { sc = n0 - 256; }
            if (n0 >= C_DQ && n0 < C_DV) {
                const int tb = n0 >= C_DK ? C_DK : C_DQ, p0 = n0 - tb, bj = p0 >> 7, wcA = (p0 >> 5) & 3;
                sc = tb - 256; offA = 64 * wcA + 32 * bj; offB = 64 * (wcA + 1) + 32 * bj;
            }
            return TrJob{w_in + (size_t)l * 1024 * 2304 + (size_t)k0 * 2304 + sc, 2304, WIN + (size_t)l * INW * 1024 + (size_t)n0 * 1024 + k0, 1024, mode, offA, offB};
        }, (LAS float*)smem);
    }
    {
        bf16_t* WOUT = (bf16_t*)(p.ws + WS_WOUT); const float* w_out = p.w_out;
        tr_stream(512, [&](int u) {
            const int l = u >> 8, rem = u & 255, nt = rem >> 4, kt = rem & 15;
            return TrJob{w_out + (size_t)l * 1024 * 1024 + (size_t)kt * 64 * 1024 + nt * 64, 1024, WOUT + (size_t)l * 1024 * 1024 + (size_t)nt * 64 * 1024 + kt * 64, 1024, 0, 0, 32};
        }, (LAS float*)smem);
    }
    {
        bf16_t* D2 = (bf16_t*)(p.ws + WS_DFT2); bf16_t* DC2 = (bf16_t*)(p.ws + WS_DFTC2);
        for (int n = blockIdx.x; n < 2048; n += gridDim.x)
            for (int m = tid; m < 2048; m += NT) {
                const float rev = (float)((n * m) & 2047) * (1.f / 2048.f);
                D2[(size_t)n * 4096 + m] = (bf16_t)f2bf(__builtin_amdgcn_cosf(rev)); D2[(size_t)n * 4096 + 2048 + m] = (bf16_t)f2bf(-__builtin_amdgcn_sinf(rev));
            }
        for (int n = blockIdx.x; n < 256; n += gridDim.x)
            if (tid < 256) {
                const float rev = (float)((n * tid) & 255) * (1.f / 256.f);
                DC2[n * 512 + tid] = (bf16_t)f2bf(__builtin_amdgcn_cosf(rev)); DC2[n * 512 + 256 + tid] = (bf16_t)f2bf(-__builtin_amdgcn_sinf(rev));
            }
    }
    if (blockIdx.x == 0 && tid < 128) {
        const int l = tid >> 6; float* CST = (float*)(p.ws + WS_CONST);
        const float lam_init = l == 0 ? 0.2f : 0.35550906759f;
        const float* dl = p.dlam + l * 128;
        float s1 = lane < 32 ? dl[lane] * dl[32 + lane] : 0.f, s2 = lane < 32 ? dl[64 + lane] * dl[96 + lane] : 0.f;
        s1 = wave_sum(s1); s2 = wave_sum(s2);
        float mq = lane < 32 ? fabsf(p.dqn[l * 32 + lane]) : 0.f, mk = lane < 32 ? fabsf(p.dkn[l * 32 + lane]) : 0.f;
        float nq = fabsf(p.nqn[l * 64 + lane]), nk = fabsf(p.nkn[l * 64 + lane]);
        float mb = 0.f;
        for (int i = lane; i < 4 * 15 * 31; i += 64) mb = fmaxf(mb, p.rpb[l * 4 * 15 * 31 + i]);
#pragma unroll
        for (int o = 1; o < 64; o <<= 1) { mq = fmaxf(mq, __shfl_xor(mq, o)); mk = fmaxf(mk, __shfl_xor(mk, o)); nq = fmaxf(nq, __shfl_xor(nq, o)); nk = fmaxf(nk, __shfl_xor(nk, o)); mb = fmaxf(mb, __shfl_xor(mb, o)); }
        if (lane == 0) {
            CST[l * 8 + 0] = expf(s1) - expf(s2) + lam_init;
            CST[l * 8 + 1] = 5.656854249f * mq * mk * 1.001f;
            CST[l * 8 + 2] = 8.f * nq * nk * 1.001f + mb;
            CST[l * 8 + 3] = 1.f - lam_init;
        }
    }
}

struct WxJob { const float* s; unsigned char* d; int pbase, pmul; };
__device__ __forceinline__ WxJob wx_job(const Params& p, int l, int u) {
    const int mat = u >> 7, e = mat < 32 ? (mat >> 1) : mat - 32, which = mat < 32 ? (mat & 1) : 2, tile = u & 127, kt = tile >> 4, nt = tile & 15;
    const size_t eoff = ((size_t)l * NE + e) * 1024 * 1024 + (size_t)kt * 128 * 1024 + nt * 64;
    const float* src = which == 0 ? p.wg : which == 1 ? p.wu : p.wd;
    WxJob j;
    j.s = src + eoff;
    j.d = (which < 2 ? p.ws + WS_WGU + (size_t)e * 2048 * 1024 : p.ws + WS_WD + (size_t)e * 1024 * 1024) + kt * 128;
    j.pbase = which < 2 ? 2 * nt * 64 + which : nt * 64; j.pmul = which < 2 ? 2 : 1;
    return j;
}
__device__ __forceinline__ void phase_wexp(const Params& p, int l, LAS char* smem, int j0, int j1, int b0, int nb) {
    LAS float* sm = (LAS float*)smem;
    const int njobs = j1;
    const int t = otid();
    const int lk = t >> 4, ln = (t & 15) * 4;
    const int on = t >> 3, ok0 = (t & 7) * 16;
    if ((int)blockIdx.x < b0 || (int)blockIdx.x >= b0 + nb) return;
    int u = j0 + ((int)blockIdx.x - b0);
    if (u >= njobs) return;
    const int u0 = u;
#define WX_LOAD(v, uu) do { const int _u = (uu); const WxJob _j = wx_job(p, l, _u < njobs ? _u : u0); \
        _Pragma("unroll") for (int i = 0; i < 4; ++i) v[i] = *(const f32x4*)(_j.s + (size_t)(lk + 32 * i) * 1024 + ln); } while (0)
#define WX_STEP(v, uu) do { \
        _Pragma("unroll") for (int i = 0; i < 4; ++i) { LAS float* q = sm + (lk + 32 * i) * 65 + ln; q[0] = v[i][0]; q[1] = v[i][1]; q[2] = v[i][2]; q[3] = v[i][3]; } \
        __syncthreads(); \
        WX_LOAD(v, (uu) + 3 * nb); \
        const WxJob jb = wx_job(p, l, (uu)); \
        float o[16]; \
        _Pragma("unroll") for (int i = 0; i < 16; ++i) o[i] = sm[(ok0 + i) * 65 + on]; \
        u32x4 w0; \
        _Pragma("unroll") for (int i = 0; i < 4; ++i) { int q = 0; q = __builtin_amdgcn_cvt_pk_fp8_f32(o[4 * i] * W8_SCALE, o[4 * i + 1] * W8_SCALE, q, false); \
            q = __builtin_amdgcn_cvt_pk_fp8_f32(o[4 * i + 2] * W8_SCALE, o[4 * i + 3] * W8_SCALE, q, true); w0[i] = (unsigned)q; } \
        const int c = jb.pbase + jb.pmul * on, cl = c & 255; \
        const int drow = (c & ~255) + 128 * ((cl >> 3) & 1) + 32 * (cl >> 6) + 8 * ((cl >> 4) & 3) + (cl & 7); \
        *(u32x4*)(jb.d + (size_t)drow * 1024 + ok0) = w0; \
        __syncthreads(); } while (0)
    f32x4 va[4], vb[4], vc[4];
    WX_LOAD(va, u); WX_LOAD(vb, u + nb); WX_LOAD(vc, u + 2 * nb);
    while (true) {
        WX_STEP(va, u); u += nb; if (u >= njobs) break;
        WX_STEP(vb, u); u += nb; if (u >= njobs) break;
        WX_STEP(vc, u); u += nb; if (u >= njobs) break;
    }
#undef WX_LOAD
#undef WX_STEP
}

template <bool XBF>
__device__ __forceinline__ void phase_norm1_t(const Params& p, int l, LAS char* smem) {
    const int tid = otid(), lane = tid & 63, wave = tid >> 6;
    const float* MODl = (const float*)(p.ws + WS_MOD) + (size_t)l * 17 * 6144;
    const float* g = p.norm1_g + l * 1024;
    bf16_t* HX = (bf16_t*)(p.ws + WS_S2);
    const void* xa = XBF ? (const void*)p.out : (const void*)p.x; const void* xb = XBF ? (const void*)(p.ws + WS_XC) : (const void*)p.ctx;
    f32x4 gg[4];
#pragma unroll
    for (int i = 0; i < 4; ++i) gg[i] = *(const f32x4*)(g + i * 256 + lane * 4);
    const int rpb = (NROW + gridDim.x - 1) / gridDim.x, rbeg = blockIdx.x * rpb, rend = min(rbeg + rpb, NROW);
    LAS float* modL = (LAS float*)smem;
    const int re_ = max(rend - 1, 0), bi0 = rbeg < NLAT ? (rbeg >> 11) : 16, bi1 = re_ < NLAT ? (re_ >> 11) : 16;
    __syncthreads();
    for (int i = tid; i < 2 * 512; i += NT) { const int s = i >= 512, k = i - s * 512; *(LAS f32x4*)(modL + s * 2048 + 4 * k) = *(const f32x4*)(MODl + (s ? bi1 : bi0) * 6144 + 4 * k); }
    __syncthreads();
    int r = rbeg + wave;
    XRaw<XBF> nx, nx2;
    if (r < rend) xraw_load<XBF>(nx, xa, xb, r, lane);
    if (r + 8 < rend) xraw_load<XBF>(nx2, xa, xb, r + 8, lane);
    int bic = -1; f32x4 shv[4], scv[4];
    auto body = [&](XRaw<XBF>& bx, const int r) {
        f32x4 v[4];
        xraw_get<XBF>(bx, v);
        xraw_load<XBF>(bx, xa, xb, min(r + 16, rend - 1), lane);
        const int bi = r < NLAT ? (r >> 11) : 16;
        if (bi != bic) { bic = bi;
#pragma unroll
            for (int i = 0; i < 4; ++i) { const LAS float* mb = modL + (bi == bi0 ? 0 : 2048) + i * 256 + lane * 4; shv[i] = *(const LAS f32x4*)mb; scv[i] = *(const LAS f32x4*)(mb + 1024); } }
        float ss = 0.f;
#pragma unroll
        for (int i = 0; i < 4; ++i) ss += v[i][0] * v[i][0] + v[i][1] * v[i][1] + v[i][2] * v[i][2] + v[i][3] * v[i][3];
        ss = wave_sum(ss);
        const float rstd = rsqrtf(ss * (1.f / 1024.f) + EPS);
#pragma unroll
        for (int i = 0; i < 4; ++i) {
            const int col = i * 256 + lane * 4;
            const f32x4 sh = shv[i], sc = scv[i];
            float o[4];
#pragma unroll
            for (int j = 0; j < 4; ++j) o[j] = v[i][j] * rstd * gg[i][j] * (1.f + sc[j]) + sh[j];
            u32x2 w; w.x = pk2(o[0], o[1]); w.y = pk2(o[2], o[3]);
            *(u32x2*)(HX + (size_t)r * 1024 + col) = w;
        }
    };
    for (; r + 8 < rend; r += 16) { body(nx, r); body(nx2, r + 8); }
    if (r < rend) body(nx, r);
    __syncthreads();
}

__device__ __forceinline__ void phase_norm1(const Params& p, int l, LAS char* smem) { if (l == 0) phase_norm1_t<false>(p, l, smem); else phase_norm1_t<true>(p, l, smem); }

template <class Epi>
__device__ __forceinline__ void gemm128(const bf16_t* __restrict__ A, size_t lda, const bf16_t* __restrict__ B, size_t ldb, int K,
                                        const bf16_t* __restrict__ A2, size_t lda2, const bf16_t* __restrict__ B2, size_t ldb2, int K2,
                                        LAS char* smem, const Epi& epi) {
    LAS bf16_t* sA = (LAS bf16_t*)smem; LAS bf16_t* sB = sA + 128 * 40;
    const int tid = otid(), lane = tid & 63, wave = tid >> 6;
    const int lr = tid >> 2, lk = (tid & 3) * 8;
    const int wm = wave >> 2, wn = wave & 3, fr = lane & 15, fq = lane >> 4;
    f32x4 acc[4][2];
#pragma unroll
    for (int i = 0; i < 4; ++i)
#pragma unroll
        for (int j = 0; j < 2; ++j) acc[i][j] = (f32x4){0.f, 0.f, 0.f, 0.f};
    for (int seg = 0; seg < 2; ++seg) {
        const bf16_t* Ap = seg ? A2 : A; const bf16_t* Bp = seg ? B2 : B;
        const size_t la = seg ? lda2 : lda, lb = seg ? ldb2 : ldb; const int Ks = seg ? K2 : K;
        if (Ks == 0) break;
        const bf16_t* ga = Ap + (size_t)lr * la + lk; const bf16_t* gb = Bp + (size_t)lr * lb + lk;
        u32x4 ra = *(const u32x4*)ga, rb = *(const u32x4*)gb;
        const int nk = Ks >> 5;
        for (int kt = 0; kt < nk; ++kt) {
            __syncthreads();
            *(LAS u32x4*)(sA + lr * 40 + lk) = ra; *(LAS u32x4*)(sB + lr * 40 + lk) = rb;
            __syncthreads();
            if (kt + 1 < nk) { ra = *(const u32x4*)(ga + (kt + 1) * 32); rb = *(const u32x4*)(gb + (kt + 1) * 32); }
            bf16x8 af[4], bfr[2];
#pragma unroll
            for (int i = 0; i < 4; ++i) af[i] = *(LAS bf16x8*)(sA + (wm * 64 + i * 16 + fr) * 40 + fq * 8);
#pragma unroll
            for (int j = 0; j < 2; ++j) bfr[j] = *(LAS bf16x8*)(sB + (wn * 32 + j * 16 + fr) * 40 + fq * 8);
#pragma unroll
            for (int i = 0; i < 4; ++i)
#pragma unroll
                for (int j = 0; j < 2; ++j) acc[i][j] = __builtin_amdgcn_mfma_f32_16x16x32_bf16(bfr[j], af[i], acc[i][j], 0, 0, 0);
        }
    }
#pragma unroll
    for (int i = 0; i < 4; ++i)
#pragma unroll
        for (int j = 0; j < 2; ++j) epi(wm * 64 + i * 16 + fr, wn * 32 + j * 16 + fq * 4, acc[i][j]);
    __syncthreads();
}


namespace pg8 {
constexpr int BM = 256, BK = 64, HALF = 128, HTB = HALF * BK * 2, STAGE_BYTES = 8 * HTB, NXCD = 8, WGM = 8;
__host__ __device__ __forceinline__ int lds_byte(int r, int c) { const int st = (r >> 4) * 2 + (c >> 5), rr = r & 15, cc = c & 31, ob = rr * 64 + cc * 2; return st * 1024 + (ob ^ (((ob >> 9) & 1) << 5)); }
__host__ __device__ __forceinline__ void stage_rc(int b, int& R, int& C) { const int st = b / 1024, sb = b % 1024, swz = sb ^ (((sb >> 9) & 1) << 5); R = (st >> 1) * 16 + swz / 64; C = (st & 1) * 32 + (swz % 64) / 2; }
__host__ __device__ __forceinline__ int perm32(int rho) { const int n = rho >> 4, i = rho & 15; return 8 * (i >> 2) + 4 * n + (i & 3); }
struct Unit { int pm, pn; };
struct Gemm { const bf16_t* A; const bf16_t* Bt; int M, N, K; const int* gidx; };
struct StaticOrder {
    int nM, nN, nwg, G, c;
    __host__ __device__ void init(int M, int N, int G_, int c_) { nM = M / BM; nN = N / BM; nwg = nM * nN; G = G_; c = c_; }
    __host__ __device__ bool next(int i, Unit& u) const {
        const long L = (long)i * G + c; if (L >= nwg) return false;
        int wgid = (int)L; { const int q = nwg / NXCD, r = nwg % NXCD, xcd = wgid % NXCD, off = wgid / NXCD; wgid = (xcd < r ? xcd * (q + 1) : r * (q + 1) + (xcd - r) * q) + off; }
        const int nig = WGM * nN, gid = wgid / nig, fm = gid * WGM, gsz = (nM - fm) < WGM ? (nM - fm) : WGM;
        u.pm = fm + ((wgid % nig) % gsz); u.pn = (wgid % nig) / gsz; return true;
    }
    __device__ __forceinline__ void a_ready(const Unit&) const {}
    __device__ __forceinline__ void done(const Unit&) const {}
};
struct ExpertOrder {
    int mt_e, nN, G, c;
    __device__ bool next(int i, Unit& u) const {
        const long L = (long)i * G + c; const int per_e = mt_e * nN; if (L >= (long)NE * per_e) return false;
        const int x = (int)(L & 7), q = (int)(L >> 3), rt = x + 8 * (q / nN), pn_l = q % nN, e = rt / mt_e, pm_l = rt % mt_e;
        u.pm = e * (MEST / 256) + pm_l; u.pn = e * nN + pn_l; return true;
    }
    __device__ __forceinline__ void a_ready(const Unit&) const {}
    __device__ __forceinline__ void done(const Unit&) const {}
};
struct FourierOrder {
    int nM, G, c;
    __device__ bool next(int i, Unit& u) const { const long L = (long)i * G + c; if (L >= (long)nM * NB) return false; u.pm = (int)L % nM; u.pn = (int)L / nM; return true; }
    __device__ __forceinline__ void a_ready(const Unit&) const {}
    __device__ __forceinline__ void done(const Unit&) const {}
};
typedef float f32x2_t __attribute__((ext_vector_type(2)));
typedef __bf16 bf16x2_t __attribute__((ext_vector_type(2)));
__device__ __forceinline__ unsigned cvt_pk_bf16(float lo, float hi) { const f32x2_t v = {lo, hi}; return __builtin_bit_cast(unsigned, __builtin_convertvector(v, bf16x2_t)); }

typedef int v8i_t __attribute__((ext_vector_type(8)));
template <class Epi, class Sched, bool GATHER = false, bool FP8 = false, int SCALE_W = 127, int SCALE_A = 127>
__device__ __forceinline__ void gemm_phase(LAS unsigned char* lds, const Gemm g, const Sched& S, const Epi& E) {
    const int tid = otid(), wid = __builtin_amdgcn_readfirstlane(tid >> 6), lane = tid & 63, wr = wid >> 2, wc = wid & 3, fr = lane & 15, fq = lane >> 4;
    const int K = g.K, Kb = FP8 ? K : 2 * K  , nt = Kb / (BK * 2);
    unsigned voffA[2], voffB[2], gC2[2]; int gR[2];
#pragma unroll
    for (int i = 0; i < 2; ++i) { int R, C; stage_rc(tid * 16 + i * 8192, R, C); const int Rb = Epi::PERM ? ((R & ~31) + perm32(R & 31)) : R;
        voffA[i] = (unsigned)(R * Kb + C * 2); voffB[i] = (unsigned)(Rb * Kb + C * 2); gR[i] = R; gC2[i] = (unsigned)C * 2u; }
    const size_t kstep = (size_t)(BK * 2);
    const size_t hstep = (size_t)HALF * Kb;
    const size_t tstep = 2 * hstep;
    const unsigned ldsw = (unsigned)wid * 1024u;
    const int aoff = lds_byte(wr * 64 + fr, fq * 8), boff = lds_byte(wc * 32 + fr, fq * 8);
#define PG8_SA(b, h) (((b) * 2 + (h)) * HTB)
#define PG8_SB(b, h) ((4 + (b) * 2 + (h)) * HTB)
#define PG8_STAGE(bufoff, gbase, voff) do { _Pragma("unroll") for (int _i = 0; _i < 2; ++_i) \
        __builtin_amdgcn_global_load_lds((const unsigned*)((const char*)(gbase) + (voff)[_i]), (LAS unsigned*)(lds + (bufoff) + ldsw + _i * 8192), 16, 0, 0); } while (0)
#define PG8_LD8(ptr_) ({ const u32x4 _l = *(const LAS u32x4*)(ptr_), _h = *(const LAS u32x4*)((ptr_) + 1024); (v8i_t){(int)_l.x, (int)_l.y, (int)_l.z, (int)_l.w, (int)_h.x, (int)_h.y, (int)_h.z, (int)_h.w}; })
#define PG8_LDA(dst, b, h) do { _Pragma("unroll") for (int m = 0; m < 4; ++m) { if constexpr (FP8) dst##8[m] = PG8_LD8(lds + PG8_SA(b, h) + aoff + m * 2048); \
        else { _Pragma("unroll") for (int k = 0; k < 2; ++k) dst[m][k] = *(const LAS bf16x8*)(lds + PG8_SA(b, h) + aoff + m * 2048 + k * 1024); } } } while (0)
#define PG8_LDB(dst, b, h) do { _Pragma("unroll") for (int n = 0; n < 2; ++n) { if constexpr (FP8) dst##8[n] = PG8_LD8(lds + PG8_SB(b, h) + boff + n * 2048); \
        else { _Pragma("unroll") for (int k = 0; k < 2; ++k) dst[n][k] = *(const LAS bf16x8*)(lds + PG8_SB(b, h) + boff + n * 2048 + k * 1024); } } } while (0)
#define PG8_MMA(ai, bj, At, Bt) do { __builtin_amdgcn_s_setprio(1); _Pragma("unroll") for (int m = 0; m < 4; ++m) _Pragma("unroll") for (int n = 0; n < 2; ++n) { \
        if constexpr (FP8) {   \
            asm volatile("v_mfma_scale_f32_16x16x128_f8f6f4 %0, %1, %2, %0, %3, %4 op_sel_hi:[0,0,0]" : "+v"(acc[ai][bj][m][n]) : "v"(Bt##8[n]), "v"(At##8[m]), "v"(scw), "v"(sca)); } \
        else { _Pragma("unroll") for (int k = 0; k < 2; ++k) acc[ai][bj][m][n] = __builtin_amdgcn_mfma_f32_16x16x32_bf16(Bt[n][k], At[m][k], acc[ai][bj][m][n], 0, 0, 0); } } \
        __builtin_amdgcn_s_setprio(0); } while (0)
#define PG8_WAIT_V(n) asm volatile("s_waitcnt vmcnt(" #n ")" ::: "memory")
#define PG8_WAIT_L(n) asm volatile("s_waitcnt lgkmcnt(" #n ")" ::: "memory")
#define PG8_BAR __builtin_amdgcn_s_barrier()
#define PG8_SCHED __builtin_amdgcn_sched_barrier(0)
    unsigned go00 = 0, go01 = 0, go10 = 0, go11 = 0, gn00 = 0, gn01 = 0, gn10 = 0, gn11 = 0;
#define PG8_GOFF(u, o00, o01, o10, o11) do { const int* _ix = g.gidx + (size_t)(u).pm * BM; \
        o00 = (unsigned)_ix[gR[0]] * (unsigned)Kb + gC2[0]; o01 = (unsigned)_ix[gR[1]] * (unsigned)Kb + gC2[1]; \
        o10 = (unsigned)_ix[HALF + gR[0]] * (unsigned)Kb + gC2[0]; o11 = (unsigned)_ix[HALF + gR[1]] * (unsigned)Kb + gC2[1]; } while (0)
#define PG8_STAGE_A(bufoff, plainptr, kt, h, nx) do { if constexpr (GATHER) { unsigned _vo[2]; \
            _vo[0] = (nx) ? ((h) ? gn10 : gn00) : ((h) ? go10 : go00); _vo[1] = (nx) ? ((h) ? gn11 : gn01) : ((h) ? go11 : go01); \
            PG8_STAGE(bufoff, (const char*)g.A + (size_t)(kt) * kstep, _vo); } else { PG8_STAGE(bufoff, plainptr, voffA); } } while (0)
    Unit cur, nxt; int ui = 0;
    if (!S.next(0, cur)) return;
    int scw = SCALE_W * 0x01010101, sca = SCALE_A * 0x01010101;
    asm volatile("" : "+v"(scw), "+v"(sca));
    f32x4 acc[2][2][4][2];
#pragma unroll
    for (int a = 0; a < 2; ++a)
#pragma unroll
        for (int b = 0; b < 2; ++b)
#pragma unroll
            for (int m = 0; m < 4; ++m)
#pragma unroll
                for (int n = 0; n < 2; ++n) acc[a][b][m][n] = (f32x4){0.f, 0.f, 0.f, 0.f};
    bf16x8 At[FP8 ? 1 : 4][2], B0[FP8 ? 1 : 2][2], B1[FP8 ? 1 : 2][2];
    v8i_t At8[FP8 ? 4 : 1], B08[FP8 ? 2 : 1], B18[FP8 ? 2 : 1];
    const char* cA = (const char*)g.A + (size_t)cur.pm * tstep; const char* cB = (const char*)g.Bt + (size_t)cur.pn * tstep;
    S.a_ready(cur);
    if constexpr (GATHER) PG8_GOFF(cur, go00, go01, go10, go11);
    PG8_STAGE(PG8_SB(0, 0), cB, voffB); PG8_STAGE_A(PG8_SA(0, 0), cA, 0, 0, false); PG8_STAGE(PG8_SB(0, 1), cB + hstep, voffB); PG8_STAGE_A(PG8_SA(0, 1), cA + hstep, 0, 1, false);
    if (wr == 1) PG8_BAR;
    PG8_WAIT_V(4); PG8_BAR;
    PG8_STAGE(PG8_SB(1, 0), cB + kstep, voffB); PG8_STAGE_A(PG8_SA(1, 0), cA + kstep, 1, 0, false); PG8_STAGE(PG8_SB(1, 1), cB + hstep + kstep, voffB);
    PG8_WAIT_V(6); PG8_BAR;
    for (;;) {
        const bool has_next = S.next(ui + 1, nxt);
        if constexpr (GATHER) { if (has_next) PG8_GOFF(nxt, gn00, gn01, gn10, gn11); else { gn00 = go00; gn01 = go01; gn10 = go10; gn11 = go11; } }
        const char* nA = has_next ? (const char*)g.A + (size_t)nxt.pm * tstep : cA; const char* nB = has_next ? (const char*)g.Bt + (size_t)nxt.pn * tstep : cB;
#pragma unroll 1
        for (int t = 0; t < nt; t += 2) {
            const bool last = (t == nt - 2);
            const char* a1 = cA + (size_t)(t + 1) * kstep;
            const char* a2 = last ? nA : cA + (size_t)(t + 2) * kstep; const char* b2 = last ? nB : cB + (size_t)(t + 2) * kstep;
            const char* a3 = a2 + kstep; const char* b3 = b2 + kstep;
            if (last && has_next) S.a_ready(nxt);
            PG8_LDB(B0, 0, 0); PG8_SCHED; PG8_LDA(At, 0, 0); PG8_STAGE_A(PG8_SA(1, 1), a1 + hstep, t + 1, 1, false);
            PG8_WAIT_L(8); PG8_BAR; PG8_WAIT_L(0); PG8_MMA(0, 0, At, B0); PG8_BAR; PG8_SCHED;
            PG8_LDB(B1, 0, 1); PG8_STAGE(PG8_SB(0, 0), b2, voffB);
            PG8_BAR; PG8_WAIT_L(0); PG8_MMA(0, 1, At, B1); PG8_BAR;
            PG8_LDA(At, 0, 1); PG8_STAGE_A(PG8_SA(0, 0), a2, (last ? 0 : t + 2), 0, last);
            PG8_BAR; PG8_WAIT_L(0); PG8_MMA(1, 0, At, B0); PG8_BAR; PG8_SCHED;
            PG8_STAGE(PG8_SB(0, 1), b2 + hstep, voffB);
            PG8_WAIT_V(6); PG8_BAR; PG8_MMA(1, 1, At, B1); PG8_BAR;
            PG8_LDB(B0, 1, 0); PG8_SCHED; PG8_LDA(At, 1, 0); PG8_STAGE_A(PG8_SA(0, 1), a2 + hstep, (last ? 0 : t + 2), 1, last);
            PG8_WAIT_L(8); PG8_BAR; PG8_WAIT_L(0); PG8_MMA(0, 0, At, B0); PG8_BAR; PG8_SCHED;
            PG8_LDB(B1, 1, 1); PG8_STAGE(PG8_SB(1, 0), b3, voffB);
            PG8_BAR; PG8_WAIT_L(0); PG8_MMA(0, 1, At, B1); PG8_BAR;
            PG8_LDA(At, 1, 1); PG8_STAGE_A(PG8_SA(1, 0), a3, (last ? 1 : t + 3), 0, last);
            PG8_BAR; PG8_WAIT_L(0); PG8_MMA(1, 0, At, B0); PG8_BAR; PG8_SCHED;
            PG8_STAGE(PG8_SB(1, 1), b3 + hstep, voffB);
            PG8_WAIT_V(6); PG8_BAR; PG8_MMA(1, 1, At, B1); PG8_BAR;
        }
        if constexpr (FP8) asm volatile("s_nop 15\n\ts_nop 15" ::: "memory");
        E(acc, cur, wr, wc, fr, fq); S.done(cur);
        if (!has_next) break;
#pragma unroll
        for (int a = 0; a < 2; ++a)
#pragma unroll
            for (int b = 0; b < 2; ++b)
#pragma unroll
                for (int m = 0; m < 4; ++m)
#pragma unroll
                    for (int n = 0; n < 2; ++n) acc[a][b][m][n] = (f32x4){0.f, 0.f, 0.f, 0.f};
        cur = nxt; cA = nA; cB = nB; ++ui; go00 = gn00; go01 = gn01; go10 = gn10; go11 = gn11;
    }
    PG8_WAIT_V(0);
    if (wr == 0) PG8_BAR;
    PG8_BAR;
#undef PG8_SA
#undef PG8_SB
#undef PG8_STAGE
#undef PG8_LDA
#undef PG8_LD8
#undef PG8_LDB
#undef PG8_MMA
#undef PG8_WAIT_V
#undef PG8_WAIT_L
#undef PG8_BAR
#undef PG8_SCHED
#undef PG8_GOFF
#undef PG8_STAGE_A
}

struct EpiInproj {
    static constexpr bool PERM = true, AFTER_DRAIN = false;
    bf16_t* PX; bf16_t* ZT2; bf16_t* VT; bf16_t* VTD; const LAS float* gl;
    __device__ __forceinline__ void operator()(const f32x4 (&acc)[2][2][4][2], const Unit& u, int wr, int wc, int fr, int fq) const {
        const int row0 = u.pm * BM + wr * 64 + fr, col0 = u.pn * BM + wc * 32 + 8 * fq;
        if (u.pn == 2 || u.pn == 3 || u.pn == 6 || u.pn == 9) {
            const bool lat = u.pm < NLAT / 256;
            const int ch0 = wc * 32 + 8 * fq;
            int cstride, bstep = HALF; size_t base0; bf16_t* bp;
            if (u.pn == 6 || u.pn == 9) {
                cstride = lat ? 2048 : 256;
                if (lat) base0 = (size_t)(u.pm >> 3) * 256 * 2048 + ((u.pm & 7) * 256 + wr * 64 + fr) + (size_t)ch0 * 2048;
                else base0 = VT_CTX_OFF + (size_t)(u.pm - NLAT / 256) * 256 * 256 + (wr * 64 + fr) + (size_t)ch0 * 256;
                bp = VT + base0; if (u.pn == 9) bp = VTD + base0;
            } else {
                const int zr0 = 128 * (wc & 1) + 32 * (wc >> 1) + 8 * fq;
                bstep = 64;
                cstride = lat ? 4096 : 512;
                if (lat) base0 = (size_t)(u.pm >> 3) * 256 * 4096 + (u.pn == 3 ? 2048 : 0) + ((u.pm & 7) * 256 + wr * 64 + fr) + (size_t)zr0 * 4096;
                else base0 = (size_t)NB * 256 * 4096 + (size_t)(u.pm - NLAT / 256) * 256 * 512 + (u.pn == 3 ? 256 : 0) + (wr * 64 + fr) + (size_t)zr0 * 512;
                bp = ZT2 + base0;
            }
#pragma unroll
            for (int bj = 0; bj < 2; ++bj)
#pragma unroll
                for (int n = 0; n < 2; ++n) {
#pragma unroll
                    for (int j = 0; j < 4; ++j) {
                        bf16_t* cp = bp + (size_t)((bj * bstep + 4 * n + j) * cstride);
#pragma unroll
                        for (int ai = 0; ai < 2; ++ai)
#pragma unroll
                            for (int m = 0; m < 4; ++m) cp[ai * HALF + m * 16] = (bf16_t)f2bf(acc[ai][bj][m][n][j]);
                    }
                    asm volatile("" ::: "memory");
                }
        } else if (u.pn == 4 || u.pn == 5) {
            const bool isq = u.pn == 4, lat = u.pm < NLAT / 256;
            const LAS float* gsrc = gl + (isq ? 0 : 32) + 8 * fq;
            const f32x4 g0 = *(const LAS f32x4*)gsrc, g1 = *(const LAS f32x4*)(gsrc + 4);
            const float qs = isq ? 0.25503486164919736f : 1.f;
            const int tok0 = row0 & 2047;
#pragma unroll
            for (int ai = 0; ai < 2; ++ai)
#pragma unroll
                for (int m = 0; m < 4; ++m) {
                    const int row = row0 + ai * HALF + m * 16;
                    f32x4 c0 = (f32x4){1.f, 1.f, 1.f, 1.f}, c1 = c0, s0 = (f32x4){0.f, 0.f, 0.f, 0.f}, s1 = s0;
                    if (lat) {
                        const int tok = tok0 + ai * HALF + m * 16;
                        const float pos = (float)((fq & 2) ? (tok & 63) : (tok >> 6));
                        const float sg = (fq & 1) ? 1.f : -1.f;
                        const float a0 = pos * 0.15915494309189535f, a1 = pos * 0.05032921210448704f, a2 = pos * 0.015915494309189534f, a3 = pos * 0.005032921210448704f;
                        const float a4 = pos * 0.0015915494309189536f, a5 = pos * 0.0005032921210448704f, a6 = pos * 0.00015915494309189535f, a7 = pos * 0.00005032921210448704f;
                        c0 = (f32x4){__builtin_amdgcn_cosf(a0), __builtin_amdgcn_cosf(a1), __builtin_amdgcn_cosf(a2), __builtin_amdgcn_cosf(a3)};
                        c1 = (f32x4){__builtin_amdgcn_cosf(a4), __builtin_amdgcn_cosf(a5), __builtin_amdgcn_cosf(a6), __builtin_amdgcn_cosf(a7)};
                        s0 = (f32x4){__builtin_amdgcn_sinf(a0), __builtin_amdgcn_sinf(a1), __builtin_amdgcn_sinf(a2), __builtin_amdgcn_sinf(a3)} * sg;
                        s1 = (f32x4){__builtin_amdgcn_sinf(a4), __builtin_amdgcn_sinf(a5), __builtin_amdgcn_sinf(a6), __builtin_amdgcn_sinf(a7)} * sg;
                    }
#pragma unroll
                    for (int bj = 0; bj < 2; ++bj) {
                        f32x4 v0 = acc[ai][bj][m][0], v1 = acc[ai][bj][m][1];
                        float ss = (v0[0] * v0[0] + v0[1] * v0[1]) + (v0[2] * v0[2] + v0[3] * v0[3]) + (v1[0] * v1[0] + v1[1] * v1[1]) + (v1[2] * v1[2] + v1[3] * v1[3]);
                        ss += __shfl_xor(ss, 16); ss += __shfl_xor(ss, 32);
                        const float rs = rsqrtf(ss * (1.f / 32.f) + EPS) * qs;
                        v0 = v0 * rs * g0; v1 = v1 * rs * g1;
                        if (lat) {
                            f32x4 p0, p1;
#pragma unroll
                            for (int j = 0; j < 4; ++j) { p0[j] = __shfl_xor(v0[j], 16); p1[j] = __shfl_xor(v1[j], 16); }
                            v0 = v0 * c0 + p0 * s0; v1 = v1 * c1 + p1 * s1;
                        }
                        u32x4 w; w.x = cvt_pk_bf16(v0[0], v0[1]); w.y = cvt_pk_bf16(v0[2], v0[3]); w.z = cvt_pk_bf16(v1[0], v1[1]); w.w = cvt_pk_bf16(v1[2], v1[3]);
                        *(u32x4*)(PX + (size_t)row * INW + col0 + bj * HALF) = w;
                    }
                }
        } else if (u.pn == 7 || u.pn == 8) {
            const bool isq = u.pn == 7;
            const LAS float* gsrc = gl + (isq ? 64 : 128) + 8 * fq;
            const f32x4 g00 = *(const LAS f32x4*)gsrc, g01 = *(const LAS f32x4*)(gsrc + 4), g10 = *(const LAS f32x4*)(gsrc + 32), g11 = *(const LAS f32x4*)(gsrc + 36);
            const float qs = isq ? 0.18033688011112042f : 1.f;
            const int lcol0 = u.pn * BM + wc * 64 + 8 * fq;
#pragma unroll
            for (int ai = 0; ai < 2; ++ai)
#pragma unroll
                for (int m = 0; m < 4; ++m) {
                    const f32x4 a0 = acc[ai][0][m][0], a1 = acc[ai][0][m][1], b0 = acc[ai][1][m][0], b1 = acc[ai][1][m][1];
                    float ss = ((a0[0] * a0[0] + a0[1] * a0[1]) + (a0[2] * a0[2] + a0[3] * a0[3]) + (a1[0] * a1[0] + a1[1] * a1[1]) + (a1[2] * a1[2] + a1[3] * a1[3]))
                             + ((b0[0] * b0[0] + b0[1] * b0[1]) + (b0[2] * b0[2] + b0[3] * b0[3]) + (b1[0] * b1[0] + b1[1] * b1[1]) + (b1[2] * b1[2] + b1[3] * b1[3]));
                    ss += __shfl_xor(ss, 16); ss += __shfl_xor(ss, 32);
                    const float rs = rsqrtf(ss * (1.f / 64.f) + EPS) * qs;
                    bf16_t* rowp = PX + (size_t)(row0 + ai * HALF + m * 16) * INW + lcol0;
                    { const f32x4 v0 = a0 * rs * g00, v1 = a1 * rs * g01;
                      u32x4 w; w.x = cvt_pk_bf16(v0[0], v0[1]); w.y = cvt_pk_bf16(v0[2], v0[3]); w.z = cvt_pk_bf16(v1[0], v1[1]); w.w = cvt_pk_bf16(v1[2], v1[3]); *(u32x4*)rowp = w; }
                    { const f32x4 v0 = b0 * rs * g10, v1 = b1 * rs * g11;
                      u32x4 w; w.x = cvt_pk_bf16(v0[0], v0[1]); w.y = cvt_pk_bf16(v0[2], v0[3]); w.z = cvt_pk_bf16(v1[0], v1[1]); w.w = cvt_pk_bf16(v1[2], v1[3]); *(u32x4*)(rowp + 32) = w; }
                }
        } else {
#pragma unroll
            for (int ai = 0; ai < 2; ++ai)
#pragma unroll
                for (int m = 0; m < 4; ++m) { bf16_t* rowp = PX + (size_t)(row0 + ai * HALF + m * 16) * INW + col0;
#pragma unroll
                    for (int bj = 0; bj < 2; ++bj) { const f32x4 v0 = acc[ai][bj][m][0], v1 = acc[ai][bj][m][1];
                        u32x4 w; w.x = cvt_pk_bf16(v0[0], v0[1]); w.y = cvt_pk_bf16(v0[2], v0[3]); w.z = cvt_pk_bf16(v1[0], v1[1]); w.w = cvt_pk_bf16(v1[2], v1[3]);
                        *(u32x4*)(rowp + bj * HALF) = w; } }
        }
    }
};
struct EpiFourier {
    static constexpr bool PERM = true, AFTER_DRAIN = false;
    bf16_t* Y; int rowbase, rows_per_b; float scale; const LAS float* hg;
    __device__ __forceinline__ void operator()(const f32x4 (&acc)[2][2][4][2], const Unit& u, int wr, int wc, int fr, int fq) const {
        const int row0 = rowbase + u.pn * rows_per_b + u.pm * BM + wr * 64 + fr, col0 = wc * 64 + 8 * fq;
        f32x4 gv[2][2];
#pragma unroll
        for (int bj = 0; bj < 2; ++bj)
#pragma unroll
            for (int n = 0; n < 2; ++n) gv[bj][n] = *(const LAS f32x4*)(hg + col0 + 32 * bj + 4 * n);
#pragma unroll
        for (int ai = 0; ai < 2; ++ai)
#pragma unroll
            for (int m = 0; m < 4; ++m) {
                float ss = 0.f;
#pragma unroll
                for (int bj = 0; bj < 2; ++bj)
#pragma unroll
                    for (int n = 0; n < 2; ++n) { const f32x4 v = acc[ai][bj][m][n] * scale; ss += (v[0] * v[0] + v[1] * v[1]) + (v[2] * v[2] + v[3] * v[3]); }
                ss += __shfl_xor(ss, 16); ss += __shfl_xor(ss, 32);
                const float rs = rsqrtf(ss * (1.f / 64.f) + EPS) * scale;
                bf16_t* rowp = Y + (size_t)(row0 + ai * HALF + m * 16) * 1024 + 256 + col0;
#pragma unroll
                for (int bj = 0; bj < 2; ++bj) { const f32x4 v0 = acc[ai][bj][m][0] * rs * gv[bj][0], v1 = acc[ai][bj][m][1] * rs * gv[bj][1];
                    u32x4 w; w.x = cvt_pk_bf16(v0[0], v0[1]); w.y = cvt_pk_bf16(v0[2], v0[3]); w.z = cvt_pk_bf16(v1[0], v1[1]); w.w = cvt_pk_bf16(v1[2], v1[3]);
                    *(u32x4*)(rowp + bj * 32) = w; } }
    }
};
struct EpiOutY {
    static constexpr bool PERM = true, AFTER_DRAIN = false;
    bf16_t* YP;
    __device__ __forceinline__ void operator()(const f32x4 (&acc)[2][2][4][2], const Unit& u, int wr, int wc, int fr, int fq) const {
        const int row0 = u.pm * BM + wr * 64 + fr, col0 = u.pn * BM + wc * 32 + 8 * fq;
#pragma unroll
        for (int ai = 0; ai < 2; ++ai)
#pragma unroll
            for (int m = 0; m < 4; ++m) { bf16_t* rowp = YP + (size_t)(row0 + ai * HALF + m * 16) * 1024 + col0;
#pragma unroll
                for (int bj = 0; bj < 2; ++bj) { const f32x4 v0 = acc[ai][bj][m][0], v1 = acc[ai][bj][m][1];
                    u32x4 w; w.x = cvt_pk_bf16(v0[0], v0[1]); w.y = cvt_pk_bf16(v0[2], v0[3]); w.z = cvt_pk_bf16(v1[0], v1[1]); w.w = cvt_pk_bf16(v1[2], v1[3]);
                    *(u32x4*)(rowp + bj * HALF) = w; } }
    }
};
struct EpiSwiglu {
    static constexpr bool PERM = true, AFTER_DRAIN = false;
    unsigned char* HID;
    __device__ __forceinline__ void operator()(const f32x4 (&acc)[2][2][4][2], const Unit& u, int wr, int wc, int fr, int fq) const {
        const int row0 = u.pm * BM + wr * 64 + fr, f00 = ((u.pn & 7) * BM + wc * 64 + 16 * fq) >> 1;
#pragma unroll
        for (int ai = 0; ai < 2; ++ai)
#pragma unroll
            for (int m = 0; m < 4; ++m) {
                u32x2 w;
#pragma unroll
                for (int bj = 0; bj < 2; ++bj) { const f32x4 v0 = acc[ai][bj][m][0], v1 = acc[ai][bj][m][1]; int q = 0;
                    q = __builtin_amdgcn_cvt_pk_fp8_f32(silu_fast(v0[0]) * v0[1] * HID8_SCALE, silu_fast(v0[2]) * v0[3] * HID8_SCALE, q, false);
                    q = __builtin_amdgcn_cvt_pk_fp8_f32(silu_fast(v1[0]) * v1[1] * HID8_SCALE, silu_fast(v1[2]) * v1[3] * HID8_SCALE, q, true); w[bj] = (unsigned)q; }
                *(u32x2*)(HID + (size_t)(row0 + ai * HALF + m * 16) * 1024 + f00) = w;
                __builtin_amdgcn_sched_barrier(0);
            }
    }
};
constexpr float O_SCALE = 8.f;
struct EpiDown {
    static constexpr bool PERM = true, AFTER_DRAIN = false;
    unsigned char* O;
    __device__ __forceinline__ void operator()(const f32x4 (&acc)[2][2][4][2], const Unit& u, int wr, int wc, int fr, int fq) const {
        const int row0 = u.pm * BM + wr * 64 + fr, col0 = (u.pn & 3) * BM + wc * 64 + 16 * fq;
#pragma unroll
        for (int ai = 0; ai < 2; ++ai)
#pragma unroll
            for (int m = 0; m < 4; ++m) {
                u32x4 w;
#pragma unroll
                for (int bj = 0; bj < 2; ++bj)
#pragma unroll
                    for (int n = 0; n < 2; ++n) { const f32x4 v = acc[ai][bj][m][n] * O_SCALE; int q = 0;
                        q = __builtin_amdgcn_cvt_pk_fp8_f32(v[0], v[1], q, false); q = __builtin_amdgcn_cvt_pk_fp8_f32(v[2], v[3], q, true); w[bj * 2 + n] = (unsigned)q; }
                *(u32x4*)(O + (size_t)(row0 + ai * HALF + m * 16) * 1024 + col0) = w;
            }
    }
};
}

__device__ __forceinline__ void phase_inproj(const Params& p, int l, LAS char* smem) {
    pg8::Gemm g{(const bf16_t*)(p.ws + WS_S2), (const bf16_t*)(p.ws + WS_WIN) + (size_t)l * INW * 1024, NROW, INW, 1024, nullptr};
    pg8::StaticOrder S; S.init(NROW, INW, gridDim.x, blockIdx.x);
    { LAS float* gl = (LAS float*)(smem + LDS_EXTRA); const int t = otid();
      if (t < 32) gl[t] = p.dqn[l * 32 + t]; else if (t < 64) gl[t] = p.dkn[l * 32 + t - 32]; else if (t < 128) gl[t] = p.nqn[l * 64 + t - 64]; else if (t < 192) gl[t] = p.nkn[l * 64 + t - 128];
      __syncthreads(); }
    pg8::EpiInproj E{(bf16_t*)(p.ws + WS_S1), (bf16_t*)(p.ws + WS_ZT), (bf16_t*)(p.ws + WS_VT), (bf16_t*)(p.ws + WS_VTD), (const LAS float*)(smem + LDS_EXTRA)};
    pg8::gemm_phase(( LAS unsigned char*)smem, g, S, E);
}

__device__ __forceinline__ void phase_qkprep(const Params& p, int l) {
    const int tid = otid(), lane = tid & 63, wave = tid >> 6;
    bf16_t* PX = (bf16_t*)(p.ws + WS_S1);
    const float* ROPE = (const float*)(p.ws + WS_ROPE);
    const int stride = gridDim.x * 8;
    int r = blockIdx.x * 8 + wave;
    u32x2 nraw[4];
    if (r < NROW) { const bf16_t* row = PX + (size_t)r * INW + lane * 4;
        nraw[0] = *(const u32x2*)(row + C_CQ); nraw[1] = *(const u32x2*)(row + C_CK); nraw[2] = *(const u32x2*)(row + C_DQ); nraw[3] = *(const u32x2*)(row + C_DK); }
    for (; r < NROW; r += stride) {
        bf16_t* row = PX + (size_t)r * INW;
        u32x2 craw[4];
#pragma unroll
        for (int i = 0; i < 4; ++i) craw[i] = nraw[i];
        if (r + stride < NROW) { const bf16_t* rown = PX + (size_t)(r + stride) * INW + lane * 4;
            nraw[0] = *(const u32x2*)(rown + C_CQ); nraw[1] = *(const u32x2*)(rown + C_CK); nraw[2] = *(const u32x2*)(rown + C_DQ); nraw[3] = *(const u32x2*)(rown + C_DK); }
        const bool lat = r < NLAT; const int n = r & 2047;
#pragma unroll
        for (int s = 0; s < 2; ++s) {
            bf16_t* pp = row + C_CQ + s * 256 + lane * 4;
            const u32x2 raw = craw[s];
            float v[4] = {bflo(raw.x), bfhi(raw.x), bflo(raw.y), bfhi(raw.y)};
            float ss = v[0] * v[0] + v[1] * v[1] + v[2] * v[2] + v[3] * v[3];
            ss += __shfl_xor(ss, 1); ss += __shfl_xor(ss, 2); ss += __shfl_xor(ss, 4);
            const float rstd = rsqrtf(ss * (1.f / 32.f) + EPS);
            const float* g = (s ? p.dkn : p.dqn) + l * 32 + (lane & 7) * 4;
            const float qs = s ? 1.f : 0.25503486164919736f;
#pragma unroll
            for (int i = 0; i < 4; ++i) v[i] = v[i] * (rstd * qs) * g[i];
            if (lat) {
                const int half = (lane >> 2) & 1, sub = lane & 3, j0 = (sub & 1) * 4;
                const float* tab = ROPE + n * 32 + half * 16;
#pragma unroll
                for (int i = 0; i < 4; ++i) {
                    const float partner = __shfl_xor(v[i], 2);
                    const float cs = tab[j0 + i], sn = tab[8 + j0 + i];
                    v[i] = (sub & 2) ? (v[i] * cs + partner * sn) : (v[i] * cs - partner * sn);
                }
            }
            u32x2 w; w.x = pk2(v[0], v[1]); w.y = pk2(v[2], v[3]);
            *(u32x2*)pp = w;
        }
#pragma unroll
        for (int s = 0; s < 2; ++s) {
            bf16_t* pp = row + C_DQ + s * 256 + lane * 4;
            const u32x2 raw = craw[2 + s];
            float v[4] = {bflo(raw.x), bfhi(raw.x), bflo(raw.y), bfhi(raw.y)};
            float ss = v[0] * v[0] + v[1] * v[1] + v[2] * v[2] + v[3] * v[3];
            ss += __shfl_xor(ss, 1); ss += __shfl_xor(ss, 2); ss += __shfl_xor(ss, 4); ss += __shfl_xor(ss, 8);
            const float rstd = rsqrtf(ss * (1.f / 64.f) + EPS);
            const float* g = (s ? p.nkn : p.nqn) + l * 64 + (lane & 15) * 4;
            const float rq = rstd * (s ? 1.f : 0.18033688011112042f);
            u32x2 w; w.x = pk2(v[0] * rq * g[0], v[1] * rq * g[1]); w.y = pk2(v[2] * rq * g[2], v[3] * rq * g[3]);
            *(u32x2*)pp = w;
        }
    }
}

__device__ __forceinline__ void phase_sgu(const Params& p, int l, int nu, LAS char* smem) {
    const int tid = otid(), lane = tid & 63, wave = tid >> 6, fr = lane & 15, g = lane >> 4;
    const bf16_t* PX = (const bf16_t*)(p.ws + WS_S1);
    bf16_t* Y = (bf16_t*)(p.ws + WS_S2) + (size_t)NROW * 1024;
    constexpr int VS = 272;
    const int q = tid >> 2, part = tid & 3, pp = wave * 16 + fr;
    int u = blockIdx.x;
    if (u >= nu) return;
    auto decode = [&](int unit, int& r0, int& h) {
        if (unit < 1024) { const int b = unit >> 6, ch = (unit >> 2) & 15; h = unit & 3; r0 = b * 2048 + ch * 128; }
        else { const int u2 = unit - 1024, b = u2 >> 3, ch = (u2 >> 2) & 1; h = u2 & 3; r0 = NLAT + b * 256 + ch * 128; }
    };
    int r0, h; decode(u, r0, h);
    bf16x8 wf[4]; float bs; f32x4 gv[4]; int hw = -1;
    u32x4 va, vb; u32x2 uu[4];
#define SGU_LOADROWS(r0_, h_, va_, vb_, uu_) do { const bf16_t* _s = PX + (size_t)((r0_) + q) * INW + C_AV + (h_) * 64 + part * 16; va_ = *(const u32x4*)_s; vb_ = *(const u32x4*)(_s + 8); \
        const bf16_t* _us = PX + (size_t)((r0_) + pp) * INW + C_AU + (h_) * 64 + 4 * g; _Pragma("unroll") for (int ct = 0; ct < 4; ++ct) uu_[ct] = *(const u32x2*)(_us + ct * 16); } while (0)
    SGU_LOADROWS(r0, h, va, vb, uu);
    for (; u < nu; u += gridDim.x) {
        if (h != hw) {
            const float* W = p.sgu_w + ((size_t)(l * 4 + h) * 128 + pp) * 128 + g * 8;
#pragma unroll
            for (int ks = 0; ks < 4; ++ks) { const f32x4 w0 = *(const f32x4*)(W + ks * 32), w1 = *(const f32x4*)(W + ks * 32 + 4);
                u32x4 w; w.x = pk2(w0[0], w0[1]); w.y = pk2(w0[2], w0[3]); w.z = pk2(w1[0], w1[1]); w.w = pk2(w1[2], w1[3]); wf[ks] = __builtin_bit_cast(bf16x8, w); }
            bs = p.sgu_b[(l * 4 + h) * 128 + pp];
#pragma unroll
            for (int ct = 0; ct < 4; ++ct) gv[ct] = *(const f32x4*)(p.head_g + l * 1024 + h * 64 + 4 * g + ct * 16);
            hw = h;
        }
        const int un = u + gridDim.x; int r0n = r0, hn = h;
        u32x4 van = va, vbn = vb; u32x2 uun[4];
#pragma unroll
        for (int ct = 0; ct < 4; ++ct) uun[ct] = uu[ct];
        if (un < nu) { decode(un, r0n, hn); SGU_LOADROWS(r0n, hn, van, vbn, uun); }
        {
            float v[16] = {bflo(va.x), bfhi(va.x), bflo(va.y), bfhi(va.y), bflo(va.z), bfhi(va.z), bflo(va.w), bfhi(va.w),
                           bflo(vb.x), bfhi(vb.x), bflo(vb.y), bfhi(vb.y), bflo(vb.z), bfhi(vb.z), bflo(vb.w), bfhi(vb.w)};
            float ss = 0.f;
#pragma unroll
            for (int i = 0; i < 16; ++i) { v[i] = gelu_tanh(v[i]); ss += v[i] * v[i]; }
            ss += __shfl_xor(ss, 1); ss += __shfl_xor(ss, 2);
            const float rstd = rsqrtf(ss * (1.f / 64.f) + EPS);
#pragma unroll
            for (int i = 0; i < 16; ++i) *(LAS bf16_t*)(smem + (part * 16 + i) * VS + q * 2) = (bf16_t)f2bf(v[i] * rstd);
        }
        __syncthreads();
        f32x4 acc[4];
#pragma unroll
        for (int ct = 0; ct < 4; ++ct) {
            acc[ct] = (f32x4){0.f, 0.f, 0.f, 0.f};
#pragma unroll
            for (int ks = 0; ks < 4; ++ks) {
                const bf16x8 af = *(const LAS bf16x8*)(smem + (ct * 16 + fr) * VS + (ks * 32 + g * 8) * 2);
                acc[ct] = __builtin_amdgcn_mfma_f32_16x16x32_bf16(af, wf[ks], acc[ct], 0, 0, 0);
            }
        }
        {
            bf16_t* yd = Y + (size_t)(r0 + pp) * 1024 + h * 64 + 4 * g;
            float o[4][4]; float ss = 0.f;
#pragma unroll
            for (int ct = 0; ct < 4; ++ct) {
                o[ct][0] = gelu_tanh(bflo(uu[ct].x)) * (acc[ct][0] + bs); o[ct][1] = gelu_tanh(bfhi(uu[ct].x)) * (acc[ct][1] + bs);
                o[ct][2] = gelu_tanh(bflo(uu[ct].y)) * (acc[ct][2] + bs); o[ct][3] = gelu_tanh(bfhi(uu[ct].y)) * (acc[ct][3] + bs);
                ss += (o[ct][0] * o[ct][0] + o[ct][1] * o[ct][1]) + (o[ct][2] * o[ct][2] + o[ct][3] * o[ct][3]);
            }
            ss += __shfl_xor(ss, 16); ss += __shfl_xor(ss, 32);
            const float rs = rsqrtf(ss * (1.f / 64.f) + EPS);
#pragma unroll
            for (int ct = 0; ct < 4; ++ct) {
                u32x2 w; w.x = pk2(o[ct][0] * rs * gv[ct][0], o[ct][1] * rs * gv[ct][1]); w.y = pk2(o[ct][2] * rs * gv[ct][2], o[ct][3] * rs * gv[ct][3]);
                *(u32x2*)(yd + ct * 16) = w;
            }
        }
        __syncthreads();
        r0 = r0n; h = hn; va = van; vb = vbn;
#pragma unroll
        for (int ct = 0; ct < 4; ++ct) uu[ct] = uun[ct];
    }
#undef SGU_LOADROWS
}

__device__ __forceinline__ void phase_fourier(const Params& p, int l, LAS char* smem) {
    bf16_t* Y = (bf16_t*)(p.ws + WS_S2) + (size_t)NROW * 1024;
    { LAS float* hl = (LAS float*)(smem + LDS_EXTRA); const int t = otid(); if (t < 256) hl[t] = p.head_g[l * 1024 + 256 + t]; __syncthreads(); }
    {
        pg8::Gemm g{(const bf16_t*)(p.ws + WS_DFT2), (const bf16_t*)(p.ws + WS_ZT), 2048, NB * 256, 4096, nullptr};
        pg8::FourierOrder S{8, (int)gridDim.x, (int)blockIdx.x};
        pg8::EpiFourier E{Y, 0, 2048, 0.0027621358640099515f, (const LAS float*)(smem + LDS_EXTRA)};
        pg8::gemm_phase((LAS unsigned char*)smem, g, S, E);
    }
    if (l == 0) {
        pg8::Gemm g{(const bf16_t*)(p.ws + WS_DFTC2), (const bf16_t*)(p.ws + WS_ZT) + (size_t)NB * 256 * 4096, 256, NB * 256, 512, nullptr};
        pg8::FourierOrder S{1, (int)gridDim.x, (int)((blockIdx.x + 128) % gridDim.x)};
        pg8::EpiFourier E{Y, NLAT, 256, 0.0078125f, (const LAS float*)(smem + LDS_EXTRA)};
        pg8::gemm_phase((LAS unsigned char*)smem, g, S, E);
    }
}

template <bool DIFF>
__device__ __forceinline__ void attn_simple_unit(const Params& p, int qrow0, int qcol, int kcol, int vcol,
                                 int k0row, int k0n, int k1row, int k1n, float scale, float Mb, float lam, int ycol, LAS char* smem) {
    const int tid = otid(), qi = tid >> 1, half = tid & 1;
    const bf16_t* PX = (const bf16_t*)(p.ws + WS_S1);
    bf16_t* Y = (bf16_t*)(p.ws + WS_S2) + (size_t)NROW * 1024;
    LAS float* sk = (LAS float*)smem;
    LAS float* sv = sk + 64 * 64;
    const int qr = qrow0 + qi;
    float q[64];
    {
        const bf16_t* src = PX + (size_t)qr * INW + qcol;
#pragma unroll
        for (int i = 0; i < 8; ++i) { const u32x4 a = *(const u32x4*)(src + i * 8);
            q[i * 8 + 0] = bflo(a.x) * scale; q[i * 8 + 1] = bfhi(a.x) * scale; q[i * 8 + 2] = bflo(a.y) * scale; q[i * 8 + 3] = bfhi(a.y) * scale;
            q[i * 8 + 4] = bflo(a.z) * scale; q[i * 8 + 5] = bfhi(a.z) * scale; q[i * 8 + 6] = bflo(a.w) * scale; q[i * 8 + 7] = bfhi(a.w) * scale; }
    }
    float o0[32], o1[32]; float l0 = 0.f, l1 = 0.f;
#pragma unroll
    for (int i = 0; i < 32; ++i) { o0[i] = 0.f; o1[i] = 0.f; }
    const int ntile = (k0n + k1n) >> 6, nt0 = k0n >> 6;
    for (int kt = 0; kt < ntile; ++kt) {
        const int krow = kt < nt0 ? k0row + kt * 64 : k1row + (kt - nt0) * 64;
        __syncthreads();
        {
            const int key = tid >> 3, part = tid & 7;
            const bf16_t* ks = PX + (size_t)(krow + key) * INW + kcol + part * 8;
            const bf16_t* vs = PX + (size_t)(krow + key) * INW + vcol + part * 8;
            const u32x4 a = *(const u32x4*)ks, b = *(const u32x4*)vs;
            LAS float* dk = sk + key * 64 + part * 8; LAS float* dv = sv + key * 64 + part * 8;
            *(LAS f32x4*)dk = (f32x4){bflo(a.x), bfhi(a.x), bflo(a.y), bfhi(a.y)}; *(LAS f32x4*)(dk + 4) = (f32x4){bflo(a.z), bfhi(a.z), bflo(a.w), bfhi(a.w)};
            *(LAS f32x4*)dv = (f32x4){bflo(b.x), bfhi(b.x), bflo(b.y), bfhi(b.y)}; *(LAS f32x4*)(dv + 4) = (f32x4){bflo(b.z), bfhi(b.z), bflo(b.w), bfhi(b.w)};
        }
        __syncthreads();
#pragma unroll 1
        for (int key = 0; key < 64; ++key) {
            float s0 = 0.f, s1 = 0.f;
#pragma unroll
            for (int d4 = 0; d4 < 8; ++d4) { const f32x4 kk = *(LAS f32x4*)(sk + key * 64 + d4 * 4);
                s0 += q[d4 * 4] * kk[0] + q[d4 * 4 + 1] * kk[1] + q[d4 * 4 + 2] * kk[2] + q[d4 * 4 + 3] * kk[3];
                if ((d4 & 3) == 3) __builtin_amdgcn_sched_barrier(0); }
#pragma unroll
            for (int d4 = 8; d4 < 16; ++d4) { const f32x4 kk = *(LAS f32x4*)(sk + key * 64 + d4 * 4);
                s1 += q[d4 * 4] * kk[0] + q[d4 * 4 + 1] * kk[1] + q[d4 * 4 + 2] * kk[2] + q[d4 * 4 + 3] * kk[3];
                if ((d4 & 3) == 3) __builtin_amdgcn_sched_barrier(0); }
            if (DIFF) {
                const float p0 = __expf(s0 - Mb), p1 = __expf(s1 - Mb);
                l0 += p0; l1 += p1;
#pragma unroll
                for (int d4 = 0; d4 < 8; ++d4) { const f32x4 vv = *(LAS f32x4*)(sv + key * 64 + half * 32 + d4 * 4);
#pragma unroll
                    for (int j = 0; j < 4; ++j) { o0[d4 * 4 + j] += p0 * vv[j]; o1[d4 * 4 + j] += p1 * vv[j]; }
                    if ((d4 & 3) == 3) __builtin_amdgcn_sched_barrier(0); }
            } else {
                const float p0 = __expf(s0 + s1 - Mb);
                l0 += p0;
#pragma unroll
                for (int d4 = 0; d4 < 8; ++d4) { const f32x4 vv = *(LAS f32x4*)(sv + key * 64 + half * 32 + d4 * 4);
#pragma unroll
                    for (int j = 0; j < 4; ++j) o0[d4 * 4 + j] += p0 * vv[j];
                    if ((d4 & 3) == 3) __builtin_amdgcn_sched_barrier(0); }
            }
        }
    }
    {
        const float i0 = 1.f / l0, i1 = DIFF ? lam / l1 : 0.f;
        bf16_t* yd = Y + (size_t)qr * 1024 + ycol + half * 32;
#pragma unroll
        for (int i = 0; i < 4; ++i) {
            float o[8];
#pragma unroll
            for (int j = 0; j < 8; ++j) o[j] = DIFF ? (o0[i * 8 + j] * i0 - o1[i * 8 + j] * i1) : o0[i * 8 + j] * i0;
            u32x4 w; w.x = pk2(o[0], o[1]); w.y = pk2(o[2], o[3]); w.z = pk2(o[4], o[5]); w.w = pk2(o[6], o[7]);
            *(u32x4*)(yd + i * 8) = w;
        }
    }
    __syncthreads();
}

__device__ __forceinline__ void na_unit(const Params& p, int l, int unit, LAS char* smem) {
    const int tid = otid(), col = tid & 63, split = tid >> 6;
    const bf16_t* PX = (const bf16_t*)(p.ws + WS_S1);
    bf16_t* Y = (bf16_t*)(p.ws + WS_S2) + (size_t)NROW * 1024;
    const float* CST = (const float*)(p.ws + WS_CONST);
    const float Mb = CST[l * 8 + 2];
    const int b = unit >> 7, h = (unit >> 5) & 3, r = unit & 31;
    const int rstart = min(max(r - 4, 0), 24), wstart = min(max(col - 8, 0), 48);
    const int qr = b * 2048 + r * 64 + col;
    LAS float* sq = (LAS float*)smem;
    __syncthreads();
    {
        const int qc = tid >> 3, part = tid & 7;
        const u32x4 a = *(const u32x4*)(PX + (size_t)(b * 2048 + r * 64 + qc) * INW + C_DQ + h * 64 + part * 8);
        LAS float* d = sq + qc * 65 + part * 8;
        d[0] = bflo(a.x) * 0.125f; d[1] = bfhi(a.x) * 0.125f; d[2] = bflo(a.y) * 0.125f; d[3] = bfhi(a.y) * 0.125f;
        d[4] = bflo(a.z) * 0.125f; d[5] = bfhi(a.z) * 0.125f; d[6] = bflo(a.w) * 0.125f; d[7] = bfhi(a.w) * 0.125f;
    }
    __syncthreads();
    float o[64]; float lsum = 0.f;
#pragma unroll
    for (int i = 0; i < 64; ++i) o[i] = 0.f;
    const int kr = rstart + split;
    const float* bias = p.rpb + ((size_t)(l * 4 + h) * 15 + (kr - r + 7)) * 31;
#pragma unroll 1
    for (int kk = 0; kk < 48; ++kk) {
        int krow; float bs = 0.f;
        if (kk < 16) { const int kc = wstart + kk; krow = b * 2048 + kr * 64 + kc; bs = bias[kc - col + 15]; }
        else krow = NLAT + b * 256 + split * 32 + (kk - 16);
        const bf16_t* ks = PX + (size_t)krow * INW + C_DK + h * 64;
        const bf16_t* vs = PX + (size_t)krow * INW + C_DV + h * 64;
        float s = bs;
#pragma unroll
        for (int i = 0; i < 8; ++i) { const u32x4 a = *(const u32x4*)(ks + i * 8); const LAS float* qq = sq + col * 65 + i * 8;
            s += qq[0] * bflo(a.x) + qq[1] * bfhi(a.x) + qq[2] * bflo(a.y) + qq[3] * bfhi(a.y)
               + qq[4] * bflo(a.z) + qq[5] * bfhi(a.z) + qq[6] * bflo(a.w) + qq[7] * bfhi(a.w); }
        const float pr = __expf(s - Mb);
        lsum += pr;
#pragma unroll
        for (int i = 0; i < 8; ++i) { const u32x4 a = *(const u32x4*)(vs + i * 8);
            o[i * 8 + 0] += pr * bflo(a.x); o[i * 8 + 1] += pr * bfhi(a.x); o[i * 8 + 2] += pr * bflo(a.y); o[i * 8 + 3] += pr * bfhi(a.y);
            o[i * 8 + 4] += pr * bflo(a.z); o[i * 8 + 5] += pr * bfhi(a.z); o[i * 8 + 6] += pr * bflo(a.w); o[i * 8 + 7] += pr * bfhi(a.w); }
    }
    LAS float* red = (LAS float*)smem;
    __syncthreads();
#pragma unroll
    for (int i = 0; i < 64; ++i) red[(split * 64 + col) * 65 + i] = o[i];
    red[(split * 64 + col) * 65 + 64] = lsum;
    __syncthreads();
    {
        const int dg = split;
        float ls = 0.f, acc[8];
#pragma unroll
        for (int j = 0; j < 8; ++j) acc[j] = 0.f;
#pragma unroll
        for (int s = 0; s < 8; ++s) { ls += red[(s * 64 + col) * 65 + 64];
#pragma unroll
            for (int j = 0; j < 8; ++j) acc[j] += red[(s * 64 + col) * 65 + dg * 8 + j]; }
        const float inv = 1.f / ls;
        u32x4 w; w.x = pk2(acc[0] * inv, acc[1] * inv); w.y = pk2(acc[2] * inv, acc[3] * inv); w.z = pk2(acc[4] * inv, acc[5] * inv); w.w = pk2(acc[6] * inv, acc[7] * inv);
        *(u32x4*)(Y + (size_t)qr * 1024 + 768 + h * 64 + dg * 8) = w;
    }
    __syncthreads();
}


__device__ __forceinline__ void diffattn_unit(const Params& p, int qrow0, int h, int krowA, int ntA, const bf16_t* vtA, int vtsA,
                                              int krowB, const bf16_t* vtB, int vtsB, int nt, float c2, float lam, const float* hg, float hs, LAS char* smem) {
    const int tid = otid(), lane = tid & 63, wave = tid >> 6, fr = lane & 15, g = lane >> 4;
    const bf16_t* PX = (const bf16_t*)(p.ws + WS_S1);
    bf16_t* Y = (bf16_t*)(p.ws + WS_S2) + (size_t)NROW * 1024;
    constexpr int KS = 160, VS = 136, TS = 64 * KS, BS = TS + 64 * VS;
    bf16x8 qf[2][2];
#pragma unroll
    for (int qt = 0; qt < 2; ++qt) { const bf16_t* qsrc = PX + (size_t)(qrow0 + wave * 32 + qt * 16 + fr) * INW + C_CQ + h * 64 + g * 8;
        qf[qt][0] = *(const bf16x8*)qsrc; qf[qt][1] = *(const bf16x8*)(qsrc + 32); }
    const int srow = tid >> 3, schunk = tid & 7;
    const int sdst = srow * KS + schunk * 16, vdst = srow * VS + schunk * 16;
    f32x4 O[2][2][4];
#pragma unroll
    for (int qt = 0; qt < 2; ++qt)
#pragma unroll
        for (int m = 0; m < 2; ++m)
#pragma unroll
            for (int dt = 0; dt < 4; ++dt) O[qt][m][dt] = (f32x4){0.f, 0.f, 0.f, 0.f};
    f32x4 L[2][2];
#pragma unroll
    for (int qt = 0; qt < 2; ++qt)
#pragma unroll
        for (int m = 0; m < 2; ++m) L[qt][m] = (f32x4){0.f, 0.f, 0.f, 0.f};
    const bf16x8 ones = {(short)0x3F80, (short)0x3F80, (short)0x3F80, (short)0x3F80, (short)0x3F80, (short)0x3F80, (short)0x3F80, (short)0x3F80};
    const f32x4 sinit = (f32x4){-c2, -c2, -c2, -c2};
    u32x4 rk, rv;
#define DA_GLOAD(t) do { const int _t = (t); \
        if (_t < ntA) { rk = *(const u32x4*)(PX + (size_t)(krowA + _t * 64 + srow) * INW + C_CK + h * 64 + schunk * 8); rv = *(const u32x4*)(vtA + (size_t)(h * 64 + srow) * vtsA + _t * 64 + schunk * 8); } \
        else { const int _u = _t - ntA; rk = *(const u32x4*)(PX + (size_t)(krowB + _u * 64 + srow) * INW + C_CK + h * 64 + schunk * 8); rv = *(const u32x4*)(vtB + (size_t)(h * 64 + srow) * vtsB + _u * 64 + schunk * 8); } } while (0)
    DA_GLOAD(0);
    *(LAS u32x4*)(smem + sdst) = rk; *(LAS u32x2*)(smem + TS + vdst) = (u32x2){rv.x, rv.y}; *(LAS u32x2*)(smem + TS + vdst + 8) = (u32x2){rv.z, rv.w};
    __syncthreads();
    for (int t = 0; t < nt; ++t) {
        if (t + 1 < nt) DA_GLOAD(t + 1);
        LAS char* kb = smem + (t & 1) * BS; LAS char* vb = kb + TS;
#pragma unroll
        for (int half = 0; half < 2; ++half) {
            bf16x8 kf[2][2], vf[4];
#pragma unroll
            for (int m = 0; m < 2; ++m)
#pragma unroll
                for (int kt = 0; kt < 2; ++kt) kf[m][kt] = *(const LAS bf16x8*)(kb + (half * 32 + kt * 16 + fr) * KS + m * 64 + g * 16);
#pragma unroll
            for (int dt = 0; dt < 4; ++dt) {
                const LAS char* vp = vb + (dt * 16 + fr) * VS + (half * 32 + 4 * g) * 2;
                const u32x2 lo = *(const LAS u32x2*)vp, hi = *(const LAS u32x2*)(vp + 32);
                u32x4 w; w.x = lo.x; w.y = lo.y; w.z = hi.x; w.w = hi.y;
                vf[dt] = __builtin_bit_cast(bf16x8, w);
            }
            __builtin_amdgcn_sched_barrier(0);
            f32x4 s[2][2][2];
#pragma unroll
            for (int m = 0; m < 2; ++m)
#pragma unroll
                for (int kt = 0; kt < 2; ++kt) {
                    s[0][m][kt] = __builtin_amdgcn_mfma_f32_16x16x32_bf16(kf[m][kt], qf[0][m], sinit, 0, 0, 0);
                    s[1][m][kt] = __builtin_amdgcn_mfma_f32_16x16x32_bf16(kf[m][kt], qf[1][m], sinit, 0, 0, 0);
                }
            bf16x8 pa[2][2];
#pragma unroll
            for (int qt = 0; qt < 2; ++qt)
#pragma unroll
                for (int m = 0; m < 2; ++m) {
                    float pv[8];
#pragma unroll
                    for (int kt = 0; kt < 2; ++kt)
#pragma unroll
                        for (int r = 0; r < 4; ++r) pv[kt * 4 + r] = __builtin_amdgcn_exp2f(s[qt][m][kt][r]);
                    u32x4 w; w.x = pg8::cvt_pk_bf16(pv[0], pv[1]); w.y = pg8::cvt_pk_bf16(pv[2], pv[3]); w.z = pg8::cvt_pk_bf16(pv[4], pv[5]); w.w = pg8::cvt_pk_bf16(pv[6], pv[7]);
                    pa[qt][m] = __builtin_bit_cast(bf16x8, w);
                    L[qt][m] = __builtin_amdgcn_mfma_f32_16x16x32_bf16(pa[qt][m], ones, L[qt][m], 0, 0, 0);
                }
#pragma unroll
            for (int dt = 0; dt < 4; ++dt)
#pragma unroll
                for (int qt = 0; qt < 2; ++qt) {
                    O[qt][0][dt] = __builtin_amdgcn_mfma_f32_16x16x32_bf16(pa[qt][0], vf[dt], O[qt][0][dt], 0, 0, 0);
                    O[qt][1][dt] = __builtin_amdgcn_mfma_f32_16x16x32_bf16(pa[qt][1], vf[dt], O[qt][1][dt], 0, 0, 0);
                }
        }
        if (t + 1 < nt) { LAS char* nb = smem + ((t + 1) & 1) * BS; *(LAS u32x4*)(nb + sdst) = rk; *(LAS u32x2*)(nb + TS + vdst) = (u32x2){rv.x, rv.y}; *(LAS u32x2*)(nb + TS + vdst + 8) = (u32x2){rv.z, rv.w}; }
        __syncthreads();
    }
#undef DA_GLOAD
    float hgv[4];
#pragma unroll
    for (int dt = 0; dt < 4; ++dt) hgv[dt] = hg[h * 64 + dt * 16 + fr] * hs;
#pragma unroll
    for (int qt = 0; qt < 2; ++qt) {
#pragma unroll
        for (int r = 0; r < 4; ++r) {
            const float i0 = 1.f / L[qt][0][r], i1 = lam / L[qt][1][r];
            float v[4], ss = 0.f;
#pragma unroll
            for (int dt = 0; dt < 4; ++dt) { v[dt] = O[qt][0][dt][r] * i0 - O[qt][1][dt][r] * i1; ss += v[dt] * v[dt]; }
            ss += __shfl_xor(ss, 1); ss += __shfl_xor(ss, 2); ss += __shfl_xor(ss, 4); ss += __shfl_xor(ss, 8);
            const float rs = rsqrtf(ss * (1.f / 64.f) + EPS);
            bf16_t* yd = Y + (size_t)(qrow0 + wave * 32 + qt * 16 + 4 * g + r) * 1024 + 512 + h * 64 + fr;
#pragma unroll
            for (int dt = 0; dt < 4; ++dt) yd[dt * 16] = (bf16_t)f2bf(v[dt] * rs * hgv[dt]);
        }
    }
}

__device__ __forceinline__ void na_mfma_unit(const Params& p, int l, int b, int h, int rp, bool ctxq, int qb, float c1, float c2, LAS char* smem) {
    const int tid = otid(), lane = tid & 63, wave = tid >> 6, fr = lane & 15, g = lane >> 4;
    const bf16_t* PX = (const bf16_t*)(p.ws + WS_S1);
    const bf16_t* VTD = (const bf16_t*)(p.ws + WS_VTD);
    bf16_t* Y = (bf16_t*)(p.ws + WS_S2) + (size_t)NROW * 1024;
    constexpr int KS = 160, VS = 136, TS = 64 * KS, BS = TS + 64 * VS;
    LAS float* tab = (LAS float*)(smem + 2 * BS);
    const int r = ctxq ? 0 : 2 * rp + (wave >> 2), j = wave & 3;
    const int qrow = ctxq ? NLAT + b * 256 + qb * 128 + wave * 16 : b * 2048 + r * 64 + 16 * j;
    const int rs = min(max(r - 4, 0), 24);
    const int kr_lo = min(max(2 * rp - 4, 0), 24), nloc = ctxq ? 0 : (min(max(2 * rp - 3, 0), 24) + 7 - kr_lo + 1), nt = nloc + 4;
    const int kstart = min(max(16 * j - 8, 0), 32), qc = 16 * j + fr, wstart = min(max(qc - 8, 0), 48);
    if (!ctxq) for (int i = tid; i < 465; i += NT) tab[i] = p.rpb[(size_t)(l * 4 + h) * 465 + i] * 1.4426950408889634f;
    const f32x4 sinit = (f32x4){-c2, -c2, -c2, -c2};
    const bf16x8 ones = {(short)0x3F80, (short)0x3F80, (short)0x3F80, (short)0x3F80, (short)0x3F80, (short)0x3F80, (short)0x3F80, (short)0x3F80};
    f32x4 Ls = (f32x4){0.f, 0.f, 0.f, 0.f};
    const bf16_t* qsrc = PX + (size_t)(qrow + fr) * INW + C_DQ + h * 64 + g * 8;
    const bf16x8 qf0 = *(const bf16x8*)qsrc, qf1 = *(const bf16x8*)(qsrc + 32);
    const int srow = tid >> 3, schunk = tid & 7, sdst = srow * KS + schunk * 16, vdst = srow * VS + schunk * 16;
    f32x4 O[4];
#pragma unroll
    for (int dt = 0; dt < 4; ++dt) O[dt] = (f32x4){0.f, 0.f, 0.f, 0.f};
    u32x4 rk, rv;
    const bf16_t* vt_lat = VTD + (size_t)b * 256 * 2048 + (size_t)(h * 64 + srow) * 2048 + schunk * 8;
    const bf16_t* vt_ctx = VTD + VT_CTX_OFF + (size_t)b * 256 * 256 + (size_t)(h * 64 + srow) * 256 + schunk * 8;
#define NA_GLOAD(t) do { const int _t = (t); \
        if (_t < nloc) { const int _kr = kr_lo + _t; rk = *(const u32x4*)(PX + (size_t)(b * 2048 + _kr * 64 + srow) * INW + C_DK + h * 64 + schunk * 8); rv = *(const u32x4*)(vt_lat + _kr * 64); } \
        else { const int _u = _t - nloc; rk = *(const u32x4*)(PX + (size_t)(NLAT + b * 256 + _u * 64 + srow) * INW + C_DK + h * 64 + schunk * 8); rv = *(const u32x4*)(vt_ctx + _u * 64); } } while (0)
    NA_GLOAD(0);
    *(LAS u32x4*)(smem + sdst) = rk; *(LAS u32x2*)(smem + TS + vdst) = (u32x2){rv.x, rv.y}; *(LAS u32x2*)(smem + TS + vdst + 8) = (u32x2){rv.z, rv.w};
    __syncthreads();
    for (int t = 0; t < nt; ++t) {
        if (t + 1 < nt) NA_GLOAD(t + 1);
        LAS char* kb = smem + (t & 1) * BS; LAS char* vb = kb + TS;
        const bool local = t < nloc; const int kr = kr_lo + t;
        const int nhalf = local ? ((kr >= rs && kr <= rs + 7) ? 1 : 0) : 2;
        for (int half = 0; half < nhalf; ++half) {
            const int koff = local ? kstart : half * 32;
            f32x4 s[2];
#pragma unroll
            for (int kt = 0; kt < 2; ++kt) {
                const LAS char* kp = kb + (koff + kt * 16 + fr) * KS + g * 16;
                const bf16x8 k0 = *(const LAS bf16x8*)kp, k1 = *(const LAS bf16x8*)(kp + 64);
                s[kt] = __builtin_amdgcn_mfma_f32_16x16x32_bf16(k0, qf0, sinit, 0, 0, 0);
                s[kt] = __builtin_amdgcn_mfma_f32_16x16x32_bf16(k1, qf1, s[kt], 0, 0, 0);
            }
            float pv[8];
            if (local) {
                const LAS float* trow = tab + (kr - r + 7) * 31;
#pragma unroll
                for (int kt = 0; kt < 2; ++kt)
#pragma unroll
                    for (int rr = 0; rr < 4; ++rr) {
                        const int kc = koff + 16 * kt + 4 * g + rr;
                        const bool valid = (kc >= wstart) && (kc < wstart + 16);
                        const float bs = trow[valid ? kc - qc + 15 : 0];
                        const float e = __builtin_amdgcn_exp2f(s[kt][rr] + bs);
                        pv[kt * 4 + rr] = valid ? e : 0.f;
                    }
            } else {
#pragma unroll
                for (int kt = 0; kt < 2; ++kt)
#pragma unroll
                    for (int rr = 0; rr < 4; ++rr) pv[kt * 4 + rr] = __builtin_amdgcn_exp2f(s[kt][rr]);
            }
            u32x4 w; w.x = pg8::cvt_pk_bf16(pv[0], pv[1]); w.y = pg8::cvt_pk_bf16(pv[2], pv[3]); w.z = pg8::cvt_pk_bf16(pv[4], pv[5]); w.w = pg8::cvt_pk_bf16(pv[6], pv[7]);
            const bf16x8 pa = __builtin_bit_cast(bf16x8, w);
            Ls = __builtin_amdgcn_mfma_f32_16x16x32_bf16(pa, ones, Ls, 0, 0, 0);
#pragma unroll
            for (int dt = 0; dt < 4; ++dt) {
                const LAS char* vp = vb + (dt * 16 + fr) * VS + (koff + 4 * g) * 2;
                const u32x2 lo = *(const LAS u32x2*)vp, hi = *(const LAS u32x2*)(vp + 32);
                u32x4 v; v.x = lo.x; v.y = lo.y; v.z = hi.x; v.w = hi.y;
                O[dt] = __builtin_amdgcn_mfma_f32_16x16x32_bf16(pa, __builtin_bit_cast(bf16x8, v), O[dt], 0, 0, 0);
            }
        }
        if (t + 1 < nt) { LAS char* nb = smem + ((t + 1) & 1) * BS; *(LAS u32x4*)(nb + sdst) = rk; *(LAS u32x2*)(nb + TS + vdst) = (u32x2){rv.x, rv.y}; *(LAS u32x2*)(nb + TS + vdst + 8) = (u32x2){rv.z, rv.w}; }
        __syncthreads();
    }
#undef NA_GLOAD
    float hgv[4];
#pragma unroll
    for (int dt = 0; dt < 4; ++dt) hgv[dt] = p.head_g[l * 1024 + 768 + h * 64 + dt * 16 + fr];
#pragma unroll
    for (int rr = 0; rr < 4; ++rr) {
        const float inv = 1.f / Ls[rr];
        float v[4], ss = 0.f;
#pragma unroll
        for (int dt = 0; dt < 4; ++dt) { v[dt] = O[dt][rr] * inv; ss += v[dt] * v[dt]; }
        ss += __shfl_xor(ss, 1); ss += __shfl_xor(ss, 2); ss += __shfl_xor(ss, 4); ss += __shfl_xor(ss, 8);
        const float rs = rsqrtf(ss * (1.f / 64.f) + EPS);
        bf16_t* yd = Y + (size_t)(qrow + 4 * g + rr) * 1024 + 768 + h * 64 + fr;
#pragma unroll
        for (int dt = 0; dt < 4; ++dt) yd[dt * 16] = (bf16_t)f2bf(v[dt] * rs * hgv[dt]);
    }
}


__device__ __forceinline__ void na_mfma_unit2(const Params& p, int l, int b, int h, int rq, float c2, LAS char* smem) {
    const int tid = otid(), lane = tid & 63, wave = tid >> 6, fr = lane & 15, g = lane >> 4;
    const bf16_t* PX = (const bf16_t*)(p.ws + WS_S1);
    const bf16_t* VTD = (const bf16_t*)(p.ws + WS_VTD);
    bf16_t* Y = (bf16_t*)(p.ws + WS_S2) + (size_t)NROW * 1024;
    constexpr int KS = 160, VS = 136, TS = 64 * KS, BS = TS + 64 * VS;
    LAS float* tab = (LAS float*)(smem + 2 * BS);
    const int j = wave & 3, r0 = 4 * rq + 2 * (wave >> 2), r1 = r0 + 1;
    const int rs0 = min(max(r0 - 4, 0), 24), rs1 = min(max(r1 - 4, 0), 24);
    const int kr_lo = min(max(4 * rq - 4, 0), 24), nloc = min(max(4 * rq - 1, 0), 24) + 7 - kr_lo + 1, nt = nloc + 4;
    const int kstart = min(max(16 * j - 8, 0), 32), qc = 16 * j + fr, wstart = min(max(qc - 8, 0), 48);
    for (int i = tid; i < 465; i += NT) tab[i] = p.rpb[(size_t)(l * 4 + h) * 465 + i] * 1.4426950408889634f;
    const f32x4 sinit = (f32x4){-c2, -c2, -c2, -c2};
    const bf16x8 ones = {(short)0x3F80, (short)0x3F80, (short)0x3F80, (short)0x3F80, (short)0x3F80, (short)0x3F80, (short)0x3F80, (short)0x3F80};
    bf16x8 qf[2][2];
#pragma unroll
    for (int qt = 0; qt < 2; ++qt) { const bf16_t* qsrc = PX + (size_t)(b * 2048 + (r0 + qt) * 64 + 16 * j + fr) * INW + C_DQ + h * 64 + g * 8;
        qf[qt][0] = *(const bf16x8*)qsrc; qf[qt][1] = *(const bf16x8*)(qsrc + 32); }
    const int srow = tid >> 3, schunk = tid & 7, sdst = srow * KS + schunk * 16, vdst = srow * VS + schunk * 16;
    f32x4 O[2][4], Ls[2];
#pragma unroll
    for (int qt = 0; qt < 2; ++qt) { Ls[qt] = (f32x4){0.f, 0.f, 0.f, 0.f};
#pragma unroll
        for (int dt = 0; dt < 4; ++dt) O[qt][dt] = (f32x4){0.f, 0.f, 0.f, 0.f}; }
    u32x4 rk, rv;
    const bf16_t* vt_lat = VTD + (size_t)b * 256 * 2048 + (size_t)(h * 64 + srow) * 2048 + schunk * 8;
    const bf16_t* vt_ctx = VTD + VT_CTX_OFF + (size_t)b * 256 * 256 + (size_t)(h * 64 + srow) * 256 + schunk * 8;
#define NA_GLOAD(t) do { const int _t = (t); \
        if (_t < nloc) { const int _kr = kr_lo + _t; rk = *(const u32x4*)(PX + (size_t)(b * 2048 + _kr * 64 + srow) * INW + C_DK + h * 64 + schunk * 8); rv = *(const u32x4*)(vt_lat + _kr * 64); } \
        else { const int _u = _t - nloc; rk = *(const u32x4*)(PX + (size_t)(NLAT + b * 256 + _u * 64 + srow) * INW + C_DK + h * 64 + schunk * 8); rv = *(const u32x4*)(vt_ctx + _u * 64); } } while (0)
    NA_GLOAD(0);
    *(LAS u32x4*)(smem + sdst) = rk; *(LAS u32x2*)(smem + TS + vdst) = (u32x2){rv.x, rv.y}; *(LAS u32x2*)(smem + TS + vdst + 8) = (u32x2){rv.z, rv.w};
    __syncthreads();
    for (int t = 0; t < nt; ++t) {
        if (t + 1 < nt) NA_GLOAD(t + 1);
        LAS char* kb = smem + (t & 1) * BS; LAS char* vb = kb + TS;
        const bool local = t < nloc; const int kr = kr_lo + t;
        const bool in0 = kr >= rs0 && kr <= rs0 + 7, in1 = kr >= rs1 && kr <= rs1 + 7;
        const int nhalf = local ? ((in0 || in1) ? 1 : 0) : 2;
        for (int half = 0; half < nhalf; ++half) {
            const int koff = local ? kstart : half * 32;
            f32x4 s[2][2];
#pragma unroll
            for (int kt = 0; kt < 2; ++kt) {
                const LAS char* kp = kb + (koff + kt * 16 + fr) * KS + g * 16;
                const bf16x8 k0 = *(const LAS bf16x8*)kp, k1 = *(const LAS bf16x8*)(kp + 64);
#pragma unroll
                for (int qt = 0; qt < 2; ++qt) {
                    s[qt][kt] = __builtin_amdgcn_mfma_f32_16x16x32_bf16(k0, qf[qt][0], sinit, 0, 0, 0);
                    s[qt][kt] = __builtin_amdgcn_mfma_f32_16x16x32_bf16(k1, qf[qt][1], s[qt][kt], 0, 0, 0);
                }
            }
            bf16x8 pa[2];
#pragma unroll
            for (int qt = 0; qt < 2; ++qt) {
                float pv[8];
                if (local) {
                    const bool inq = qt ? in1 : in0;
                    const LAS float* trow = tab + (inq ? (kr - (r0 + qt) + 7) * 31 : 0);
#pragma unroll
                    for (int kt = 0; kt < 2; ++kt)
#pragma unroll
                        for (int rr = 0; rr < 4; ++rr) {
                            const int kc = koff + 16 * kt + 4 * g + rr;
                            const bool valid = inq && (kc >= wstart) && (kc < wstart + 16);
                            const float bs = trow[valid ? kc - qc + 15 : 0];
                            const float e = __builtin_amdgcn_exp2f(s[qt][kt][rr] + bs);
                            pv[kt * 4 + rr] = valid ? e : 0.f;
                        }
                } else {
#pragma unroll
                    for (int kt = 0; kt < 2; ++kt)
#pragma unroll
                        for (int rr = 0; rr < 4; ++rr) pv[kt * 4 + rr] = __builtin_amdgcn_exp2f(s[qt][kt][rr]);
                }
                u32x4 w; w.x = pg8::cvt_pk_bf16(pv[0], pv[1]); w.y = pg8::cvt_pk_bf16(pv[2], pv[3]); w.z = pg8::cvt_pk_bf16(pv[4], pv[5]); w.w = pg8::cvt_pk_bf16(pv[6], pv[7]);
                pa[qt] = __builtin_bit_cast(bf16x8, w);
                Ls[qt] = __builtin_amdgcn_mfma_f32_16x16x32_bf16(pa[qt], ones, Ls[qt], 0, 0, 0);
            }
#pragma unroll
            for (int dt = 0; dt < 4; ++dt) {
                const LAS char* vp = vb + (dt * 16 + fr) * VS + (koff + 4 * g) * 2;
                const u32x2 lo = *(const LAS u32x2*)vp, hi = *(const LAS u32x2*)(vp + 32);
                u32x4 v; v.x = lo.x; v.y = lo.y; v.z = hi.x; v.w = hi.y;
                const bf16x8 vf = __builtin_bit_cast(bf16x8, v);
                O[0][dt] = __builtin_amdgcn_mfma_f32_16x16x32_bf16(pa[0], vf, O[0][dt], 0, 0, 0);
                O[1][dt] = __builtin_amdgcn_mfma_f32_16x16x32_bf16(pa[1], vf, O[1][dt], 0, 0, 0);
            }
        }
        if (t + 1 < nt) { LAS char* nb = smem + ((t + 1) & 1) * BS; *(LAS u32x4*)(nb + sdst) = rk; *(LAS u32x2*)(nb + TS + vdst) = (u32x2){rv.x, rv.y}; *(LAS u32x2*)(nb + TS + vdst + 8) = (u32x2){rv.z, rv.w}; }
        __syncthreads();
    }
#undef NA_GLOAD
    float hgv[4];
#pragma unroll
    for (int dt = 0; dt < 4; ++dt) hgv[dt] = p.head_g[l * 1024 + 768 + h * 64 + dt * 16 + fr];
#pragma unroll
    for (int qt = 0; qt < 2; ++qt)
#pragma unroll
        for (int rr = 0; rr < 4; ++rr) {
            const float inv = 1.f / Ls[qt][rr];
            float v[4], ss = 0.f;
#pragma unroll
            for (int dt = 0; dt < 4; ++dt) { v[dt] = O[qt][dt][rr] * inv; ss += v[dt] * v[dt]; }
            ss += __shfl_xor(ss, 1); ss += __shfl_xor(ss, 2); ss += __shfl_xor(ss, 4); ss += __shfl_xor(ss, 8);
            const float rs = rsqrtf(ss * (1.f / 64.f) + EPS);
            bf16_t* yd = Y + (size_t)(b * 2048 + (r0 + qt) * 64 + 16 * j + 4 * g + rr) * 1024 + 768 + h * 64 + fr;
#pragma unroll
            for (int dt = 0; dt < 4; ++dt) yd[dt * 16] = (bf16_t)f2bf(v[dt] * rs * hgv[dt]);
        }
}

__device__ __forceinline__ void phase_mix(const Params& p, int l, LAS char* smem) {
    const float* CST = (const float*)(p.ws + WS_CONST);
    const float lam = CST[l * 8 + 0], MbD = CST[l * 8 + 1], MbN = CST[l * 8 + 2];
    const float sc32 = 0.17677669529663687f;
    const bf16_t* VT = (const bf16_t*)(p.ws + WS_VT);
    const float c2 = MbD * 1.4426950408889634f;
    for (int rep = 0; rep < 1 + (REP_MIX & 1); ++rep)
    for (int u = blockIdx.x; u < 512; u += gridDim.x) {
        const int b = u >> 5, h = (u >> 3) & 3, qb = u & 7;
        diffattn_unit(p, b * 2048 + qb * 256, h, b * 2048, 32, VT + (size_t)b * 256 * 2048, 2048, NLAT + b * 256, VT + VT_CTX_OFF + (size_t)b * 256 * 256, 256, 36, c2, lam, p.head_g + l * 1024 + 512, CST[l * 8 + 3], smem);
    }
    for (int rep = 0; rep < 1 + ((REP_MIX >> 1) & 1); ++rep) phase_fourier(p, l, smem);
    const float c1n = 0.125f * 1.4426950408889634f, c2n = MbN * 1.4426950408889634f;
    for (int rep = 0; rep < 1 + ((REP_MIX >> 2) & 1); ++rep)
    if (gridDim.x == 256) {
        const int c = blockIdx.x, u0 = c < 128 ? c : 128 + (c - 128) * 3, nu = c < 128 ? 1 : 3;
        for (int u = u0; u < u0 + nu; ++u) na_mfma_unit2(p, l, u >> 5, (u >> 3) & 3, u & 7, c2n, smem);
    } else
    for (int u = blockIdx.x; u < 512; u += gridDim.x) na_mfma_unit2(p, l, u >> 5, (u >> 3) & 3, u & 7, c2n, smem);
    for (int rep = 0; rep < 1 + ((REP_MIX >> 3) & 1); ++rep) phase_sgu(p, l, (l == 0) ? 1152 : 1024, smem);
    for (int rep = 0; rep < 1 + ((REP_MIX >> 4) & 1); ++rep)
    if (l == 0) {
        for (int u = (gridDim.x == 256 ? (int)blockIdx.x - 128 : (int)blockIdx.x); u >= 0 && u < 128; u += gridDim.x) {
            const int which = u >> 6, b = (u >> 2) & 15, h = u & 3, r0 = NLAT + b * 256;
            if (which == 0) {
                diffattn_unit(p, r0, h, r0, 4, VT + VT_CTX_OFF + (size_t)b * 256 * 256, 256, r0, VT, 0, 4, c2, lam, p.head_g + l * 1024 + 512, CST[l * 8 + 3], smem);
            } else {
#pragma unroll 1
                for (int qb = 0; qb < 2; ++qb) na_mfma_unit(p, l, b, h, 0, true, qb, c1n, c2n, smem);
            }
        }
    }
}

__device__ __forceinline__ void phase_merge(const Params& p, int l) {
    const int tid = otid(), lane = tid & 63, wave = tid >> 6;
    bf16_t* Y = (bf16_t*)(p.ws + WS_S2) + (size_t)NROW * 1024;
    const float* CST = (const float*)(p.ws + WS_CONST);
    const int nrow = (l == 0) ? NROW : NLAT;
    const int head = lane >> 2;
    const float hs = (head >= 8 && head < 12) ? CST[l * 8 + 3] : 1.f;
    const float* g = p.head_g + l * 1024 + lane * 16;
    const int stride = gridDim.x * 8;
    int r = blockIdx.x * 8 + wave;
    u32x4 na, nb;
    if (r < nrow) { const bf16_t* pn = Y + (size_t)r * 1024 + lane * 16; na = *(const u32x4*)pn; nb = *(const u32x4*)(pn + 8); }
    for (; r < nrow; r += stride) {
        bf16_t* pp = Y + (size_t)r * 1024 + lane * 16;
        const u32x4 a = na, b = nb;
        if (r + stride < nrow) { const bf16_t* pn = Y + (size_t)(r + stride) * 1024 + lane * 16; na = *(const u32x4*)pn; nb = *(const u32x4*)(pn + 8); }
        float v[16] = {bflo(a.x), bfhi(a.x), bflo(a.y), bfhi(a.y), bflo(a.z), bfhi(a.z), bflo(a.w), bfhi(a.w),
                       bflo(b.x), bfhi(b.x), bflo(b.y), bfhi(b.y), bflo(b.z), bfhi(b.z), bflo(b.w), bfhi(b.w)};
        float ss = 0.f;
#pragma unroll
        for (int i = 0; i < 16; ++i) ss += v[i] * v[i];
        ss += __shfl_xor(ss, 1); ss += __shfl_xor(ss, 2);
        const float rstd = rsqrtf(ss * (1.f / 64.f) + EPS) * hs;
#pragma unroll
        for (int i = 0; i < 16; ++i) v[i] = v[i] * rstd * g[i];
        u32x4 w0, w1;
        w0.x = pk2(v[0], v[1]); w0.y = pk2(v[2], v[3]); w0.z = pk2(v[4], v[5]); w0.w = pk2(v[6], v[7]);
        w1.x = pk2(v[8], v[9]); w1.y = pk2(v[10], v[11]); w1.z = pk2(v[12], v[13]); w1.w = pk2(v[14], v[15]);
        *(u32x4*)pp = w0; *(u32x4*)(pp + 8) = w1;
    }
}

__device__ __forceinline__ void phase_outproj(const Params& p, int l, LAS char* smem) {
    const int nrow = (l == 0) ? NROW : NLAT;
    pg8::Gemm g{(const bf16_t*)(p.ws + WS_S2) + (size_t)NROW * 1024, (const bf16_t*)(p.ws + WS_WOUT) + (size_t)l * 1024 * 1024, nrow, 1024, 1024, nullptr};
    pg8::StaticOrder S; S.init(nrow, 1024, gridDim.x, blockIdx.x);
    pg8::EpiOutY E{(bf16_t*)(p.ws + WS_S2)};
    pg8::gemm_phase((LAS unsigned char*)smem, g, S, E);
}

template <bool XBF>
__device__ __forceinline__ void phase_router_t(const Params& p, int l, LAS char* smem) {
    const int tid = otid(), lane = tid & 63, wave = tid >> 6;
    LAS float* rwT = (LAS float*)smem;
    for (int i = tid; i < 1024 * 16; i += NT) rwT[(i & 15) * 1024 + (i >> 4)] = p.router_w[(size_t)l * 1024 * 16 + i];
    const float* MODl = (const float*)(p.ws + WS_MOD) + (size_t)l * 17 * 6144;
    LAS float* modL = (LAS float*)(smem + 65536);
    const int nrow_ = (l == 0) ? NROW : NLAT;
    const int rpb_ = (nrow_ + gridDim.x - 1) / gridDim.x, rb_ = blockIdx.x * rpb_, re_ = max(min(rb_ + rpb_, nrow_) - 1, 0);
    const int bi0 = rb_ < NLAT ? (rb_ >> 11) : 16, bi1 = re_ < NLAT ? (re_ >> 11) : 16;
    for (int i = tid; i < 2 * 768; i += NT) { const int s = i >= 768, k = i - s * 768; *(LAS f32x4*)(modL + s * 3072 + 4 * k) = *(const f32x4*)(MODl + (s ? bi1 : bi0) * 6144 + 2048 + 4 * k); }
    __syncthreads();
    const float* g = p.norm2_g + l * 1024;
    bf16_t* HN = (bf16_t*)(p.ws + WS_S2);
    unsigned char* HN8 = (unsigned char*)(p.ws + WS_S2) + HN8_OFF;
    float* AFF = (float*)(p.ws + WS_AFF);
    const int nrow = (l == 0) ? NROW : NLAT;
    const void* xa = XBF ? (const void*)p.out : (const void*)p.x; const void* xb = XBF ? (const void*)(p.ws + WS_XC) : (const void*)p.ctx;
    f32x4 gg[4];
#pragma unroll
    for (int i = 0; i < 4; ++i) gg[i] = *(const f32x4*)(g + i * 256 + lane * 4);
    const int rpb = (nrow + gridDim.x - 1) / gridDim.x, rbeg = blockIdx.x * rpb, rend = min(rbeg + rpb, nrow);
    int r = rbeg + wave;
    XRaw<XBF> nx, nx2; u32x2 ny[4], ny2[4];
    if (r < rend) { xraw_load<XBF>(nx, xa, xb, r, lane); const bf16_t* ys = HN + (size_t)r * 1024 + lane * 4;
#pragma unroll
        for (int i = 0; i < 4; ++i) ny[i] = *(const u32x2*)(ys + i * 256); }
    if (r + 8 < rend) { const int r1 = r + 8; xraw_load<XBF>(nx2, xa, xb, r1, lane); const bf16_t* ys = HN + (size_t)r1 * 1024 + lane * 4;
#pragma unroll
        for (int i = 0; i < 4; ++i) ny2[i] = *(const u32x2*)(ys + i * 256); }
    int bic = -1; f32x4 g1v[4], shv[4], scv[4];
    auto body = [&](XRaw<XBF>& bx, u32x2 (&by)[4], const int r) {
        f32x4 v[4]; u32x2 yv[4];
        xraw_get<XBF>(bx, v);
#pragma unroll
        for (int i = 0; i < 4; ++i) yv[i] = by[i];
        { const int rn = min(r + 16, rend - 1);
          xraw_load<XBF>(bx, xa, xb, rn, lane); const bf16_t* ys = HN + (size_t)rn * 1024 + lane * 4;
#pragma unroll
          for (int i = 0; i < 4; ++i) by[i] = *(const u32x2*)(ys + i * 256); }
        const int bi = r < NLAT ? (r >> 11) : 16;
        if (bi != bic) { bic = bi;
#pragma unroll
            for (int i = 0; i < 4; ++i) { const LAS float* mb = modL + (bi == bi0 ? 0 : 3072) + i * 256 + lane * 4;
                g1v[i] = *(const LAS f32x4*)mb; shv[i] = *(const LAS f32x4*)(mb + 1024); scv[i] = *(const LAS f32x4*)(mb + 2048); } }
        {
            bf16_t* xo = (bf16_t*)(p.ws + WS_ZT) + (size_t)r * 1024 + lane * 4;
#pragma unroll
            for (int i = 0; i < 4; ++i) {
                const f32x4 g1 = g1v[i];
                v[i][0] += g1[0] * bflo(yv[i].x); v[i][1] += g1[1] * bfhi(yv[i].x); v[i][2] += g1[2] * bflo(yv[i].y); v[i][3] += g1[3] * bfhi(yv[i].y);
                u32x2 w; w.x = pk2(v[i][0], v[i][1]); w.y = pk2(v[i][2], v[i][3]);
                *(u32x2*)(xo + i * 256) = w;
            }
        }
        float ss = 0.f;
#pragma unroll
        for (int i = 0; i < 4; ++i) ss += v[i][0] * v[i][0] + v[i][1] * v[i][1] + v[i][2] * v[i][2] + v[i][3] * v[i][3];
        ss = wave_sum(ss);
        const float rstd = rsqrtf(ss * (1.f / 1024.f) + EPS);
#pragma unroll
        for (int i = 0; i < 4; ++i) {
            const int col = i * 256 + lane * 4;
            const f32x4 sh = shv[i], sc = scv[i];
#pragma unroll
            for (int j = 0; j < 4; ++j) v[i][j] = v[i][j] * rstd * gg[i][j] * (1.f + sc[j]) + sh[j];
            int q = 0; q = __builtin_amdgcn_cvt_pk_fp8_f32(v[i][0], v[i][1], q, false); q = __builtin_amdgcn_cvt_pk_fp8_f32(v[i][2], v[i][3], q, true);
            *(int*)(HN8 + (size_t)r * 1024 + col) = q;
        }
        float pe[16];
#pragma unroll
        for (int e2 = 0; e2 < 16; e2 += 2) {
            f32x4 w[2][4];
#pragma unroll
            for (int q = 0; q < 2; ++q)
#pragma unroll
                for (int i = 0; i < 4; ++i) w[q][i] = *(LAS f32x4*)(rwT + (e2 + q) * 1024 + i * 256 + lane * 4);
            __builtin_amdgcn_sched_barrier(0);
            hwf32x2_t s2[2][2];
#pragma unroll
            for (int q = 0; q < 2; ++q) { s2[q][0] = (hwf32x2_t){0.f, 0.f}; s2[q][1] = (hwf32x2_t){0.f, 0.f}; }
#pragma unroll
            for (int i = 0; i < 4; ++i)
#pragma unroll
                for (int q = 0; q < 2; ++q) {
                    s2[q][0] = __builtin_elementwise_fma((hwf32x2_t){v[i][0], v[i][1]}, (hwf32x2_t){w[q][i][0], w[q][i][1]}, s2[q][0]);
                    s2[q][1] = __builtin_elementwise_fma((hwf32x2_t){v[i][2], v[i][3]}, (hwf32x2_t){w[q][i][2], w[q][i][3]}, s2[q][1]);
                }
#pragma unroll
            for (int q = 0; q < 2; ++q) { const hwf32x2_t t = s2[q][0] + s2[q][1]; pe[e2 + q] = t[0] + t[1]; }
            __builtin_amdgcn_sched_barrier(0);
        }
        float q8[8], q4[4], q2[2], q1;
        { const bool hi = lane & 32;
#pragma unroll
          for (int i = 0; i < 8; ++i) { const float keep = hi ? pe[i + 8] : pe[i], send = hi ? pe[i] : pe[i + 8]; q8[i] = keep + __shfl_xor(send, 32); } }
        { const bool hi = lane & 16;
#pragma unroll
          for (int i = 0; i < 4; ++i) { const float keep = hi ? q8[i + 4] : q8[i], send = hi ? q8[i] : q8[i + 4]; q4[i] = keep + __shfl_xor(send, 16); } }
        { const bool hi = lane & 8;
#pragma unroll
          for (int i = 0; i < 2; ++i) { const float keep = hi ? q4[i + 2] : q4[i], send = hi ? q4[i] : q4[i + 2]; q2[i] = keep + __shfl_xor(send, 8); } }
        { const bool hi = lane & 4; const float keep = hi ? q2[1] : q2[0], send = hi ? q2[0] : q2[1]; q1 = keep + __shfl_xor(send, 4); }
        q1 += __shfl_xor(q1, 2); q1 += __shfl_xor(q1, 1);
        float mx = q1;
        mx = fmaxf(mx, __shfl_xor(mx, 4)); mx = fmaxf(mx, __shfl_xor(mx, 8)); mx = fmaxf(mx, __shfl_xor(mx, 16)); mx = fmaxf(mx, __shfl_xor(mx, 32));
        const float ex = expf(q1 - mx);
        float sum = ex;
        sum += __shfl_xor(sum, 4); sum += __shfl_xor(sum, 8); sum += __shfl_xor(sum, 16); sum += __shfl_xor(sum, 32);
        if ((lane & 3) == 0) AFF[(size_t)(lane >> 2) * NROW + r] = ex / sum;
    };
    for (; r + 8 < rend; r += 16) { body(nx, ny, r); body(nx2, ny2, r + 8); }
    if (r < rend) body(nx, ny, r);
    __syncthreads();
}

__device__ __forceinline__ void phase_router(const Params& p, int l, LAS char* smem) { if (l == 0) phase_router_t<false>(p, l, smem); else phase_router_t<true>(p, l, smem); }

__device__ __forceinline__ void phase_topk(const Params& p, int l, LAS char* smem) {
    const int tid = otid(), lane = tid & 63, wave = tid >> 6;
    LAS int* hist = (LAS int*)smem;
    LAS int* sc = hist + 768;
    const float* AFF = (const float*)(p.ws + WS_AFF);
    int* IDX = (int*)(p.ws + WS_IDX); float* GATE = (float*)(p.ws + WS_GATE); int* INV = (int*)(p.ws + WS_INV);
    const int nunits = (l == 0) ? 512 : 256;
    for (int u = blockIdx.x; u < nunits; u += gridDim.x) {
        int n, cap, r0, pos0; const int e = u & 15, b = (u >> 4) & 15;
        if (u < 256) { n = 2048; cap = CAPL; r0 = b * 2048; pos0 = b * CAPL; }
        else { n = 256; cap = CAPC; r0 = NLAT + b * 256; pos0 = NB * CAPL + b * CAPC; }
        const bool have = 4 * tid < n;
        f32x4 a = (f32x4){0.f, 0.f, 0.f, 0.f};
        if (have) a = *(const f32x4*)(AFF + (size_t)e * NROW + r0 + 4 * tid);
        const unsigned uu[4] = {__float_as_uint(a[0]), __float_as_uint(a[1]), __float_as_uint(a[2]), __float_as_uint(a[3])};
        hist[tid] = 0; if (tid < 256) hist[512 + tid] = 0;
        __syncthreads();
        unsigned prefix = 0u; int remaining = cap;
#pragma unroll
        for (int pass = 0; pass < 4; ++pass) {
            const int shift = 24 - 8 * pass;
            LAS int* H = hist + (pass % 3) * 256;
            const unsigned hmask = pass == 0 ? 0u : (0xFFFFFFFFu << (shift + 8));
#pragma unroll
            for (int i = 0; i < 4; ++i)
                if (have && ((uu[i] & hmask) == prefix)) __hip_atomic_fetch_add(H + ((uu[i] >> shift) & 255u), 1, __ATOMIC_RELAXED, __HIP_MEMORY_SCOPE_WORKGROUP);
            if (pass == 2 && tid < 256) hist[tid] = 0;
            __syncthreads();
            const LAS int* hp = H + 4 * lane;
            const int h0 = hp[0], h1 = hp[1], h2 = hp[2], h3 = hp[3];
            const int t = h0 + h1 + h2 + h3;
            int suf = t;
#pragma unroll
            for (int o = 1; o < 64; o <<= 1) { const int v = __shfl_down(suf, o); if (lane + o < 64) suf += v; }
            const int a3 = suf - t, a2 = a3 + h3, a1 = a2 + h2, a0 = a1 + h1;
            const bool has = a3 < remaining && remaining <= suf;
            int dg, nr;
            if (remaining <= a2) { dg = 3; nr = remaining - a3; } else if (remaining <= a1) { dg = 2; nr = remaining - a2; } else if (remaining <= a0) { dg = 1; nr = remaining - a1; } else { dg = 0; nr = remaining - a0; }
            const unsigned long long bm = __ballot(has);
            const int src = __ffsll((long long)bm) - 1;
            const int digit = __shfl(4 * lane + dg, src);
            remaining = __shfl(nr, src);
            prefix |= (unsigned)digit << shift;
        }
        const unsigned T = prefix; const int cgt = cap - remaining;
        int cg = 0, ce = 0;
#pragma unroll
        for (int i = 0; i < 4; ++i) { cg += (have && uu[i] > T) ? 1 : 0; ce += (have && uu[i] == T) ? 1 : 0; }
        const int packed = cg | (ce << 16);
        int incl = packed;
#pragma unroll
        for (int o = 1; o < 64; o <<= 1) { const int v = __shfl_up(incl, o); if (lane >= o) incl += v; }
        if (lane == 63) sc[16 + wave] = incl;
        __syncthreads();
        int woff = 0;
#pragma unroll
        for (int w = 0; w < 8; ++w) woff += (w < wave) ? sc[16 + w] : 0;
        const int excl = woff + incl - packed;
        int bg = excl & 0xffff, be = excl >> 16;
        if (have) {
            int sl[4];
#pragma unroll
            for (int i = 0; i < 4; ++i) {
                const int r = r0 + 4 * tid + i; int slot = -1;
                if (uu[i] > T) slot = bg++;
                else if (uu[i] == T) { const int s2 = cgt + be++; if (s2 < cap) slot = s2; }
                if (slot >= 0) { IDX[e * MEST + pos0 + slot] = r; GATE[e * MEST + pos0 + slot] = a[i]; }
                sl[i] = slot >= 0 ? pos0 + slot : -1;
            }
            *(int4*)(INV + (size_t)e * NROW + r0 + 4 * tid) = make_int4(sl[0], sl[1], sl[2], sl[3]);
        }
        __syncthreads();
    }
}

__device__ __forceinline__ void phase_gather(const Params& p, int l) {
    const int tid = otid(), lane = tid & 63, wave = tid >> 6;
    const unsigned char* HN8 = (const unsigned char*)(p.ws + WS_S2) + HN8_OFF;
    unsigned char* XG8 = (unsigned char*)(p.ws + WS_S1) + XG8_OFF;
    const int* IDX = (const int*)(p.ws + WS_IDX);
    const int me = (l == 0) ? MEST : NB * CAPL;
    for (int g0 = (blockIdx.x * 8 + wave) * 4; g0 < NE * me; g0 += gridDim.x * 32) {
        const int e = g0 / me, pos = g0 % me;
        int rr[4];
#pragma unroll
        for (int i = 0; i < 4; ++i) rr[i] = IDX[e * MEST + pos + i];
        u32x4 a[4];
#pragma unroll
        for (int i = 0; i < 4; ++i) a[i] = *(const u32x4*)(HN8 + (size_t)rr[i] * 1024 + lane * 16);
#pragma unroll
        for (int i = 0; i < 4; ++i) *(u32x4*)(XG8 + ((size_t)e * MEST + pos + i) * 1024 + lane * 16) = a[i];
    }
}

__device__ __forceinline__ void phase_gemm1(const Params& p, int l, LAS char* smem) {
    pg8::Gemm g{(const bf16_t*)(p.ws + WS_S2 + HN8_OFF), (const bf16_t*)(p.ws + WS_WGU), NE * MEST, NE * 2048, 1024, (const int*)(p.ws + WS_IDX)};
    pg8::ExpertOrder S{(l == 0) ? MEST / 256 : (NB * CAPL) / 256, 8, (int)gridDim.x, (int)blockIdx.x};
    pg8::EpiSwiglu E{(unsigned char*)(p.ws + WS_S1)};
    pg8::gemm_phase<pg8::EpiSwiglu, pg8::ExpertOrder, true, true, 122, 127>((LAS unsigned char*)smem, g, S, E);
}
__device__ __forceinline__ void phase_gemm2(const Params& p, int l, LAS char* smem) {
    pg8::Gemm g{(const bf16_t*)(p.ws + WS_S1), (const bf16_t*)(p.ws + WS_WD), NE * MEST, NE * 1024, 1024, nullptr};
    pg8::ExpertOrder S{(l == 0) ? MEST / 256 : (NB * CAPL) / 256, 4, (int)gridDim.x, (int)blockIdx.x};
    pg8::EpiDown E{(unsigned char*)(p.ws + WS_S2)};
    pg8::gemm_phase<pg8::EpiDown, pg8::ExpertOrder, false, true, 122, 125>((LAS unsigned char*)smem, g, S, E);
}

__device__ __forceinline__ void phase_combine(const Params& p, int l, LAS char* smem) {
    const int tid = otid(), lane = tid & 63, wave = tid >> 6;
    const unsigned char* O = (const unsigned char*)(p.ws + WS_S2); const int* INV = (const int*)(p.ws + WS_INV); const float* GATE = (const float*)(p.ws + WS_GATE);
    const float* MODl = (const float*)(p.ws + WS_MOD) + (size_t)l * 17 * 6144;
    const int nrow = (l == 0) ? NROW : NLAT;
    float* xl0 = p.out; float* xl1 = (float*)(p.ws + WS_XC);
    const int rpb = (nrow + gridDim.x - 1) / gridDim.x, rbeg = blockIdx.x * rpb, rend = min(rbeg + rpb, nrow);
    const bf16_t* X1B = (const bf16_t*)(p.ws + WS_ZT);
    LAS int* linv = (LAS int*)smem;
    LAS float* modL = (LAS float*)(smem + 32768);
    const int re_ = max(rend - 1, 0), bi0 = rbeg < NLAT ? (rbeg >> 11) : 16, bi1 = re_ < NLAT ? (re_ >> 11) : 16;
    __syncthreads();
    for (int i = tid; i < 16 * rpb; i += NT) { const int e = i / rpb, k = i - e * rpb; linv[k * 16 + e] = (rbeg + k < rend) ? INV[(size_t)e * NROW + rbeg + k] : -1; }
    for (int i = tid; i < 2 * 256; i += NT) { const int s = i >= 256, k = i - s * 256; *(LAS f32x4*)(modL + s * 1024 + 4 * k) = *(const f32x4*)(MODl + (s ? bi1 : bi0) * 6144 + 5120 + 4 * k); }
    __syncthreads();
    if (rbeg >= rend) return;
    struct RowBuf { u32x4 xa, xb, ea[4]; float gt[4], gm[4]; };
    auto fetch = [&](RowBuf& B, const int rr) {
        const int r = min(rr, rend - 1);
        const bf16_t* xr = X1B + (size_t)r * 1024 + lane * 16; B.xa = *(const u32x4*)xr; B.xb = *(const u32x4*)(xr + 8);
        const int inv = linv[(r - rbeg) * 16 + (lane & 15)];
        unsigned mask = (unsigned)(__ballot(inv >= 0) & 0xffffull);
#pragma unroll
        for (int j = 0; j < 4; ++j) {
            const int e = mask ? __builtin_ctz(mask) : 0; const bool on = mask != 0; mask &= mask - 1;
            const int pos = on ? __shfl(inv, e) : 0;
            B.gt[j] = GATE[e * MEST + pos]; B.gm[j] = on ? (1.f / pg8::O_SCALE) : 0.f;
            B.ea[j] = *(const u32x4*)(O + ((size_t)e * MEST + pos) * 1024 + lane * 16);
        }
    };
    int bic = -1; f32x4 g2v[4];
    auto body = [&](RowBuf& B, const int r) {
        float acc[16];
#pragma unroll
        for (int i = 0; i < 16; ++i) acc[i] = 0.f;
#pragma unroll
        for (int j = 0; j < 4; ++j) { const float gt = B.gt[j] * B.gm[j];
#pragma unroll
            for (int wq = 0; wq < 4; ++wq) { const int w = (int)B.ea[j][wq];
                acc[wq * 4 + 0] += gt * __builtin_amdgcn_cvt_f32_fp8(w, 0); acc[wq * 4 + 1] += gt * __builtin_amdgcn_cvt_f32_fp8(w, 1);
                acc[wq * 4 + 2] += gt * __builtin_amdgcn_cvt_f32_fp8(w, 2); acc[wq * 4 + 3] += gt * __builtin_amdgcn_cvt_f32_fp8(w, 3); } }
        const u32x4 xa_ = B.xa, xb_ = B.xb;
        const int inv = linv[(r - rbeg) * 16 + (lane & 15)];
        unsigned long long mask = __ballot(inv >= 0) & 0xffffull;
        fetch(B, r + 16);
        if (__builtin_popcountll(mask) > 4) {
            mask &= mask - 1; mask &= mask - 1; mask &= mask - 1; mask &= mask - 1;
            while (mask) {
                const int e = __builtin_ctzll(mask); mask &= mask - 1;
                const int pos = __shfl(inv, e);
                const float gt = GATE[e * MEST + pos] * (1.f / pg8::O_SCALE);
                const u32x4 a = *(const u32x4*)(O + ((size_t)e * MEST + pos) * 1024 + lane * 16);
#pragma unroll
                for (int wq = 0; wq < 4; ++wq) { const int w = (int)a[wq];
                    acc[wq * 4 + 0] += gt * __builtin_amdgcn_cvt_f32_fp8(w, 0); acc[wq * 4 + 1] += gt * __builtin_amdgcn_cvt_f32_fp8(w, 1);
                    acc[wq * 4 + 2] += gt * __builtin_amdgcn_cvt_f32_fp8(w, 2); acc[wq * 4 + 3] += gt * __builtin_amdgcn_cvt_f32_fp8(w, 3); }
            }
        }
        const int bi = r < NLAT ? (r >> 11) : 16;
        if (bi != bic) { bic = bi;
#pragma unroll
            for (int q4 = 0; q4 < 4; ++q4) g2v[q4] = *(const LAS f32x4*)(modL + (bi == bi0 ? 0 : 1024) + lane * 16 + q4 * 4); }
        const float x1v[16] = {bflo(xa_.x), bfhi(xa_.x), bflo(xa_.y), bfhi(xa_.y), bflo(xa_.z), bfhi(xa_.z), bflo(xa_.w), bfhi(xa_.w),
                               bflo(xb_.x), bfhi(xb_.x), bflo(xb_.y), bfhi(xb_.y), bflo(xb_.z), bfhi(xb_.z), bflo(xb_.w), bfhi(xb_.w)};
        f32x4 o4[4];
#pragma unroll
        for (int q4 = 0; q4 < 4; ++q4) {
            const f32x4 gv = g2v[q4];
#pragma unroll
            for (int j = 0; j < 4; ++j) o4[q4][j] = x1v[q4 * 4 + j] + gv[j] * acc[q4 * 4 + j];
        }
        if (l == 0) {
            bf16_t* xr = (r < NLAT ? (bf16_t*)xl0 + (size_t)r * D : (bf16_t*)xl1 + (size_t)(r - NLAT) * D) + lane * 16;
            u32x4 wa, wb;
            wa.x = pk2(o4[0][0], o4[0][1]); wa.y = pk2(o4[0][2], o4[0][3]); wa.z = pk2(o4[1][0], o4[1][1]); wa.w = pk2(o4[1][2], o4[1][3]);
            wb.x = pk2(o4[2][0], o4[2][1]); wb.y = pk2(o4[2][2], o4[2][3]); wb.z = pk2(o4[3][0], o4[3][1]); wb.w = pk2(o4[3][2], o4[3][3]);
            *(u32x4*)xr = wa; *(u32x4*)(xr + 8) = wb;
        } else {
            float* xr = xl0 + (size_t)r * D + lane * 16;
            *(f32x4*)xr = o4[0]; *(f32x4*)(xr + 4) = o4[1]; *(f32x4*)(xr + 8) = o4[2]; *(f32x4*)(xr + 12) = o4[3];
        }
    };
    RowBuf A, B;
    int r = rbeg + wave;
    fetch(A, r); fetch(B, r + 8);
    for (; r + 8 < rend; r += 16) { body(A, r); body(B, r + 8); }
    if (r < rend) body(A, r);
}

constexpr int PH_PER_LAYER = 12, N_PHASES = 1 + 2 * PH_PER_LAYER;
constexpr int WX_JOBS = 48 * 128, WX_TAIL_IN = 96 * 8, WX_TAIL_OUT = 192 * 8, WX_TAIL_G2 = 128 * 8;
__device__ __forceinline__ int wx_first_job(int l, int G) { return (l == 1 && G == 256) ? WX_TAIL_G2 : 0; }
__device__ __forceinline__ int wx_main_jobs(int l) { return WX_JOBS - WX_TAIL_IN - (l == 0 ? WX_TAIL_OUT : 0); }
__global__ void __launch_bounds__(NT) mega(Params p) {
    extern __shared__ __attribute__((aligned(16))) unsigned char lds_raw[];
    LAS char* smem = (LAS char*)lds_raw;
#if MK_ONE_LAUNCH
    volatile LAS unsigned* st = (volatile LAS unsigned*)(smem + LDS_BYTES - 16);
    if (threadIdx.x == 0) { st[0] = 0u; st[1] = 0u; }
    __syncthreads();
    XcdBarrier bar = xcd_barrier_post((unsigned*)(p.ws + WS_CTL) + 4096, st);
#endif
    for (int ph = p.ph_lo; ph < p.ph_hi; ++ph) {
#if REP_MASK
        const int s_ = ph == 0 ? 12 : (ph - 1) % PH_PER_LAYER;
        const int reps = ((REP_MASK >> s_) & 1) ? 2 : 1;
        for (int rep = 0; rep < reps; ++rep) {
        if (rep) xcd_barrier(bar);
#endif
        if (ph == 0) phase_prep(p, smem);
        else {
            const int l = (ph - 1) / PH_PER_LAYER, s = (ph - 1) % PH_PER_LAYER;
            switch (s) {
                case 0: phase_wexp(p, l, smem, wx_first_job(l, gridDim.x), wx_main_jobs(l), 0, gridDim.x); phase_norm1(p, l, smem); break;
                case 1: phase_inproj(p, l, smem); if (gridDim.x == 256) phase_wexp(p, l, smem, wx_main_jobs(l), wx_main_jobs(l) + WX_TAIL_IN, 160, 96); else phase_wexp(p, l, smem, wx_main_jobs(l), wx_main_jobs(l) + WX_TAIL_IN, 0, gridDim.x); break;
                case 2: break;
                case 3: phase_mix(p, l, smem); break;
                case 4: break;
                case 5: phase_outproj(p, l, smem); if (l == 0) { if (gridDim.x == 256) phase_wexp(p, l, smem, WX_JOBS - WX_TAIL_OUT, WX_JOBS, 64, 192); else phase_wexp(p, l, smem, WX_JOBS - WX_TAIL_OUT, WX_JOBS, 0, gridDim.x); } break;
                case 6: phase_router(p, l, smem); break;
                case 7: phase_topk(p, l, smem); break;
                case 8: break;
                case 9: phase_gemm1(p, l, smem); break;
                case 10: phase_gemm2(p, l, smem); if (l == 0 && gridDim.x == 256) phase_wexp(p, 1, smem, 0, WX_TAIL_G2, 128, 128); break;
                default: phase_combine(p, l, smem); break;
            }
        }
#if REP_MASK
        }
#endif
#if MK_ONE_LAUNCH
        if (ph + 1 < p.ph_hi && !(ph > 0 && ((ph - 1) % PH_PER_LAYER == 4 || (ph - 1) % PH_PER_LAYER == 2 || (ph - 1) % PH_PER_LAYER == 8))) xcd_barrier(bar);
#endif
    }
}

extern "C" void kernel_launch(void* const* d_in, const int* in_sizes, int n_in, void* d_out, int out_size, void* d_ws, size_t ws_size, hipStream_t stream) {
    static int grid = 0;
    if (grid == 0) {
        if (n_in != 23 || ws_size < WS_END) { fprintf(stderr, "kernel_launch: unexpected n_in %d / ws_size %zu\n", n_in, ws_size); grid = -1; return; }
        int dev = 0, cus = 0, per_cu = 0;
        if (hipGetDevice(&dev) != hipSuccess || hipDeviceGetAttribute(&cus, hipDeviceAttributeMultiprocessorCount, dev) != hipSuccess) { grid = -1; return; }
        if (hipFuncSetAttribute((const void*)mega, hipFuncAttributeMaxDynamicSharedMemorySize, LDS_BYTES) != hipSuccess) { fprintf(stderr, "kernel_launch: hipFuncSetAttribute failed\n"); grid = -1; return; }
        if (hipOccupancyMaxActiveBlocksPerMultiprocessor(&per_cu, (const void*)mega, NT, LDS_BYTES) != hipSuccess || per_cu < 1) { fprintf(stderr, "kernel_launch: occupancy query says %d blocks/CU\n", per_cu); per_cu = 1; }
        (void)hipGetLastError();
        grid = cus;
        if (grid < 32) { fprintf(stderr, "kernel_launch: the row passes need at least 32 workgroups (a block's rows must lie in at most two batches)\n"); grid = -1; return; }
    }
    if (grid < 0) return;
    Params p{};
    const float** pp = (const float**)&p;
    for (int i = 0; i < 23; ++i) pp[i] = (const float*)d_in[i];
    p.out = (float*)d_out; p.ws = (unsigned char*)d_ws;
#if MK_ONE_LAUNCH
    (void)hipMemsetAsync((char*)d_ws + WS_CTL, 0, CTL_BYTES, stream);
    p.ph_lo = 0; p.ph_hi = N_PHASES;
    hipLaunchKernelGGL(mega, dim3(grid), dim3(NT), LDS_BYTES, stream, p);
#else
    for (int ph = 0; ph < N_PHASES; ++ph) {
        p.ph_lo = ph; p.ph_hi = ph + 1;
        hipLaunchKernelGGL(mega, dim3(grid), dim3(NT), LDS_BYTES, stream, p);
    }
#endif
}
```

```cpp
#include <hip/hip_runtime.h>
#include <stdint.h>
#include <cstdio>

#ifndef MK_ONE_LAUNCH
#define MK_ONE_LAUNCH 1
#endif

#ifndef REP_MIX
#define REP_MIX 0
#endif
#ifndef REP_MASK
#define REP_MASK 0
#endif
#define LAS __attribute__((address_space(3)))
typedef unsigned short bf16_t;
typedef float f32x4 __attribute__((ext_vector_type(4)));
typedef short bf16x8 __attribute__((ext_vector_type(8)));
typedef unsigned u32x2 __attribute__((ext_vector_type(2)));
typedef unsigned u32x4 __attribute__((ext_vector_type(4)));

constexpr int D = 1024, NB = 16, SEQ = 2048, CTXL = 256;
constexpr int NLAT = NB * SEQ, NCTX = NB * CTXL, NROW = NLAT + NCTX;
constexpr int INW = 2560;
constexpr int C_AU = 0, C_AV = 256, C_ZC = 512, C_ZS = 768, C_CQ = 1024, C_CK = 1280, C_CV = 1536, C_DQ = 1792, C_DK = 2048, C_DV = 2304;
constexpr int NE = 16, CAPL = 256, CAPC = 32, MEST = NB * CAPL + NB * CAPC;
constexpr int NT = 512;
constexpr float EPS = 1e-6f;
constexpr int LDS_BYTES = 147456;
constexpr int LDS_EXTRA = 131072;

constexpr size_t MiB = 1u << 20;
constexpr size_t WS_CTL = 0, CTL_BYTES = 1 * MiB;
constexpr size_t WS_MOD = 1 * MiB;
constexpr size_t WS_ROPE = 2 * MiB;
constexpr size_t WS_CONST = 2 * MiB + 512 * 1024;
constexpr size_t WS_WIN = 3 * MiB;
constexpr size_t WS_WOUT = 13 * MiB;
constexpr size_t WS_DFT2 = 17 * MiB;
constexpr size_t WS_DFTC2 = 2 * MiB + 640 * 1024;
constexpr size_t WS_WGU = 33 * MiB;
constexpr size_t WS_WD = 97 * MiB;
constexpr size_t WS_XC = 129 * MiB;
constexpr size_t WS_AFF = 145 * MiB;
constexpr size_t WS_IDX = 148 * MiB;
constexpr size_t WS_GATE = 148 * MiB + 512 * 1024;
constexpr size_t WS_INV = 149 * MiB;
constexpr size_t WS_ZT = 152 * MiB;
constexpr size_t WS_VT = 188 * MiB;
constexpr size_t WS_VTD = 206 * MiB;
constexpr size_t WS_S2 = 224 * MiB;
constexpr size_t WS_S1 = 368 * MiB;
constexpr size_t WS_END = 548 * MiB;
constexpr size_t VT_CTX_OFF = (size_t)NB * 256 * 2048;
constexpr size_t HN8_OFF = (size_t)NROW * 1024 * 2;
constexpr float W8_SCALE = 32.f, HID8_SCALE = 4.f;
constexpr size_t XG8_OFF = (size_t)NE * MEST * 1024;

struct Params {
    const float *x, *c, *ctx, *c_ctx, *ada_w, *ada_b, *norm1_g, *norm2_g, *w_in, *w_out, *head_g, *sgu_w, *sgu_b,
                *dqn, *dkn, *dlam, *nqn, *nkn, *rpb, *router_w, *wg, *wu, *wd;
    float* out; unsigned char* ws;
    int ph_lo, ph_hi;
};

typedef float hwf32x2_t __attribute__((ext_vector_type(2)));
typedef __bf16 hwbf16x2_t __attribute__((ext_vector_type(2)));
__device__ __forceinline__ unsigned pk2(float lo, float hi) { const hwf32x2_t v = {lo, hi}; return __builtin_bit_cast(unsigned, __builtin_convertvector(v, hwbf16x2_t)); }
__device__ __forceinline__ unsigned f2bf(float f) { return pk2(f, 0.f) & 0xffffu; }
__device__ __forceinline__ float bf2f(unsigned h) { return __uint_as_float(h << 16); }
__device__ __forceinline__ float bflo(unsigned w) { return __uint_as_float(w << 16); }
__device__ __forceinline__ float bfhi(unsigned w) { return __uint_as_float(w & 0xffff0000u); }
__device__ __forceinline__ float wave_sum(float v) {
#pragma unroll
    for (int o = 1; o < 64; o <<= 1) v += __shfl_xor(v, o);
    return v;
}
__device__ __forceinline__ int otid() { int t = threadIdx.x; asm volatile("" : "+v"(t)); return t; }
__device__ __forceinline__ float gelu_tanh(float x) {
    const float y2 = -2.302208198f * (x + 0.044715f * x * x * x);
    return x * __builtin_amdgcn_rcpf(1.f + __builtin_amdgcn_exp2f(y2));
}
__device__ __forceinline__ float silu_f(float v) { return v / (1.f + expf(-v)); }
__device__ __forceinline__ float silu_fast(float v) { return v * __builtin_amdgcn_rcpf(1.f + __builtin_amdgcn_exp2f(-1.4426950408889634f * v)); }

__device__ __forceinline__ const float* xrow(const Params& p, int l, int r) {
    if (l == 0) return r < NLAT ? p.x + (size_t)r * D : p.ctx + (size_t)(r - NLAT) * D;
    return r < NLAT ? p.out + (size_t)r * D : (const float*)(p.ws + WS_XC) + (size_t)(r - NLAT) * D;
}
__device__ __forceinline__ float* xlrow(const Params& p, int r) {
    return r < NLAT ? p.out + (size_t)r * D : (float*)(p.ws + WS_XC) + (size_t)(r - NLAT) * D;
}

template <bool XBF> struct XRaw { u32x4 q[XBF ? 2 : 4]; };
template <bool XBF> __device__ __forceinline__ void xraw_load(XRaw<XBF>& d, const void* lat, const void* ctx, int r, int lane) {
    if constexpr (XBF) { const bf16_t* s = (r < NLAT ? (const bf16_t*)lat + (size_t)r * D : (const bf16_t*)ctx + (size_t)(r - NLAT) * D) + lane * 4;
        const u32x2 a = *(const u32x2*)s, b = *(const u32x2*)(s + 256), c = *(const u32x2*)(s + 512), e = *(const u32x2*)(s + 768);
        d.q[0] = (u32x4){a.x, a.y, b.x, b.y}; d.q[1] = (u32x4){c.x, c.y, e.x, e.y}; }
    else { const float* s = (r < NLAT ? (const float*)lat + (size_t)r * D : (const float*)ctx + (size_t)(r - NLAT) * D) + lane * 4;
#pragma unroll
        for (int i = 0; i < 4; ++i) d.q[i] = *(const u32x4*)(s + i * 256); }
}
template <bool XBF> __device__ __forceinline__ void xraw_get(const XRaw<XBF>& d, f32x4 (&v)[4]) {
    if constexpr (XBF) { v[0] = (f32x4){bflo(d.q[0].x), bfhi(d.q[0].x), bflo(d.q[0].y), bfhi(d.q[0].y)}; v[1] = (f32x4){bflo(d.q[0].z), bfhi(d.q[0].z), bflo(d.q[0].w), bfhi(d.q[0].w)};
                         v[2] = (f32x4){bflo(d.q[1].x), bfhi(d.q[1].x), bflo(d.q[1].y), bfhi(d.q[1].y)}; v[3] = (f32x4){bflo(d.q[1].z), bfhi(d.q[1].z), bflo(d.q[1].w), bfhi(d.q[1].w)}; }
    else {
#pragma unroll
        for (int i = 0; i < 4; ++i) v[i] = __builtin_bit_cast(f32x4, d.q[i]); }
}

#define XB_TMO      128
#define XB_XCNT(j)  (256  + 64 * (j))
#define XB_XSUB(j)  (1280 + 64 * (j))
#define XB_XGEN(j)  (2304 + 64 * (j))
#define XB_TOP      3328
#define XB_TOPGEN   3392
#define XCD_BAR_WORDS 3456
#define XB_SPIN_CAP (1u << 20)
__device__ __forceinline__ unsigned xb_ld(unsigned* p)              { return __hip_atomic_load(p, __ATOMIC_RELAXED, __HIP_MEMORY_SCOPE_AGENT); }
__device__ __forceinline__ unsigned xb_add(unsigned* p, unsigned v) { return __hip_atomic_fetch_add(p, v, __ATOMIC_RELAXED, __HIP_MEMORY_SCOPE_AGENT); }
__device__ __forceinline__ unsigned xb_xcc_id() { return (unsigned)__builtin_amdgcn_s_getreg((3 << 11) | 20) & 0xFu; }
#define XB_SPIN(cond, bar) do { unsigned _sp = 0; while (cond) { __builtin_amdgcn_s_sleep(1); \
    if ((++_sp & 255u) == 0u) { if (xb_ld(&(bar)[XB_TMO])) break; if (_sp > XB_SPIN_CAP) { atomicAdd(&(bar)[XB_TMO], 1u); break; } } } } while (0)
struct XcdBarrier { unsigned* bar; unsigned x; volatile LAS unsigned* st; };
__device__ __forceinline__ XcdBarrier xcd_barrier_post(unsigned* bar, volatile LAS unsigned* st) {
    XcdBarrier b; b.bar = bar; b.x = xb_xcc_id(); b.st = st;
    if (threadIdx.x == 0) (void)xb_add(&bar[XB_XCNT(b.x)], 1u);
    return b;
}
__device__ __forceinline__ void xcd_barrier_complete(unsigned* bar, unsigned x, unsigned& nloc, unsigned& nx) {
    const unsigned G = gridDim.x * gridDim.y * gridDim.z;
    unsigned sum, cnt, mine, sp = 0u;
    for (;;) {
        sum = 0u; cnt = 0u; mine = 0u;
#pragma unroll
        for (unsigned j = 0; j < 16; ++j) { const unsigned c = xb_ld(&bar[XB_XCNT(j)]); sum += c; cnt += (c > 0u) ? 1u : 0u; mine = (j == x) ? c : mine; }
        if (sum == G) break;
        __builtin_amdgcn_s_sleep(1);
        if ((++sp & 255u) == 0u) { if (xb_ld(&bar[XB_TMO])) break; if (sp > XB_SPIN_CAP) { atomicAdd(&bar[XB_TMO], 1u); break; } }
    }
    nloc = mine > 0u ? mine : 1u; nx = cnt > 0u ? cnt : 1u;
}
__device__ __forceinline__ void xcd_barrier(const XcdBarrier& b) {
    asm volatile("s_waitcnt vmcnt(0)" ::: "memory");
    __syncthreads();
    if (threadIdx.x == 0) {
        unsigned* bar = b.bar;
        __builtin_amdgcn_s_waitcnt(0);
        unsigned nloc = b.st[0], nx = b.st[1];
        if (nloc == 0u) { xcd_barrier_complete(bar, b.x, nloc, nx); b.st[0] = nloc; b.st[1] = nx; }
        const unsigned old = xb_add(&bar[XB_XSUB(b.x)], 1u);
        const unsigned gen = old / nloc;
        if (old + 1u == (gen + 1u) * nloc) {
            __builtin_amdgcn_fence(__ATOMIC_RELEASE, "agent");
            asm volatile("s_waitcnt vmcnt(0)" ::: "memory");
            const unsigned og = xb_add(&bar[XB_TOP], 1u);
            const unsigned tg = og / nx;
            if (og + 1u == (tg + 1u) * nx) xb_add(&bar[XB_TOPGEN], 1u);
            else XB_SPIN(xb_ld(&bar[XB_TOPGEN]) == tg, bar);
            __builtin_amdgcn_fence(__ATOMIC_ACQUIRE, "agent");
            xb_add(&bar[XB_XGEN(b.x)], 1u);
            asm volatile("s_waitcnt vmcnt(0)" ::: "memory");
        } else {
            XB_SPIN(xb_ld(&bar[XB_XGEN(b.x)]) == gen, bar);
            __builtin_amdgcn_fence(__ATOMIC_ACQUIRE, "agent");
            asm volatile("s_waitcnt vmcnt(0)" ::: "memory");
        }
    }
    __syncthreads();
}

struct TrJob { const float* src; size_t ld_src; bf16_t* dst; size_t ld_dst; int mode, offA, offB; };
__device__ __forceinline__ void tr_load(const TrJob& j, f32x4 (&v)[2]) {
    const int t = otid();
#pragma unroll
    for (int i = 0; i < 2; ++i) {
        const int k = (t >> 4) + 32 * i, n = (t & 15) * 4;
        v[i] = *(const f32x4*)(j.src + (size_t)k * j.ld_src + (n < 32 ? j.offA : j.offB) + (n & 31));
    }
}
__device__ __forceinline__ void tr_lds_in(const f32x4 (&v)[2], LAS float* sm) {
    const int t = otid();
    LAS float* tab = sm + 64 * 65;
    if (t < 64) { const float a = (float)t * (1.f / 64.f); tab[t] = __builtin_amdgcn_cosf(a); tab[64 + t] = __builtin_amdgcn_sinf(a); }
#pragma unroll
    for (int i = 0; i < 2; ++i) {
        const int k = (t >> 4) + 32 * i, n = (t & 15) * 4;
        sm[k * 65 + n + 0] = v[i][0]; sm[k * 65 + n + 1] = v[i][1]; sm[k * 65 + n + 2] = v[i][2]; sm[k * 65 + n + 3] = v[i][3];
    }
}
__device__ __forceinline__ void tr_lds_out(const TrJob& j, LAS float* sm) {
    const int t = otid();
    LAS float* tab = sm + 64 * 65;
    const int n = t >> 3, k0 = (t & 7) * 8;
    float o[8];
    if (j.mode == 0) {
#pragma unroll
        for (int i = 0; i < 8; ++i) o[i] = sm[(k0 + i) * 65 + n];
    } else {
        LAS float* tb = tab + (j.mode == 2 ? 64 : 0);
#pragma unroll
        for (int i = 0; i < 8; ++i) o[i] = 0.f;
        for (int cp = 0; cp < 64; ++cp) {
            const float w = tb[(cp * n) & 63];
#pragma unroll
            for (int i = 0; i < 8; ++i) o[i] += sm[(k0 + i) * 65 + cp] * w;
        }
    }
    u32x4 w; w.x = pk2(o[0], o[1]); w.y = pk2(o[2], o[3]); w.z = pk2(o[4], o[5]); w.w = pk2(o[6], o[7]);
    *(u32x4*)(j.dst + (size_t)n * j.ld_dst + k0) = w;
}
template <class Getter>
__device__ __forceinline__ void tr_stream(int njobs, const Getter& get, LAS float* sm) {
    int u = blockIdx.x;
    if (u >= njobs) return;
    TrJob cur = get(u), nxt = cur; f32x4 v[2], vn[2];
    tr_load(cur, v);
    for (; u < njobs; u += gridDim.x) {
        const int un = u + gridDim.x;
        tr_lds_in(v, sm);
        __syncthreads();
        if (un < njobs) { nxt = get(un); tr_load(nxt, vn); }
        tr_lds_out(cur, sm);
        __syncthreads();
        cur = nxt; v[0] = vn[0]; v[1] = vn[1];
    }
}

__device__ __forceinline__ void phase_prep(const Params& p, LAS char* smem) {
    const int tid = otid(), lane = tid & 63, wave = tid >> 6;
    float* MOD = (float*)(p.ws + WS_MOD);
    for (int u = blockIdx.x; u < 192; u += gridDim.x) {
        const int l = u / 96, c0 = (u % 96) * 64;
        LAS float* s = (LAS float*)smem;
        LAS float* red = s + 17 * 1024;
        for (int i = tid; i < 17 * 1024; i += NT) { const float v = (i < 16 * 1024) ? p.c[i] : p.c_ctx[i - 16 * 1024]; s[i] = silu_f(v); }
        __syncthreads();
        float acc[17];
#pragma unroll
        for (int bi = 0; bi < 17; ++bi) acc[bi] = 0.f;
        const float* W = p.ada_w + (size_t)l * 1024 * 6144 + c0 + lane;
        for (int k = wave; k < 1024; k += 256) {
            float a[32];
#pragma unroll
            for (int j = 0; j < 32; ++j) a[j] = W[(size_t)(k + 8 * j) * 6144];
#pragma unroll
            for (int j = 0; j < 32; ++j)
#pragma unroll
                for (int bi = 0; bi < 17; ++bi) acc[bi] += s[bi * 1024 + k + 8 * j] * a[j];
        }
#pragma unroll
        for (int bi = 0; bi < 17; ++bi) red[(wave * 17 + bi) * 64 + lane] = acc[bi];
        __syncthreads();
        for (int i = tid; i < 17 * 64; i += NT) {
            const int bi = i >> 6, cc = i & 63; float sum = 0.f;
#pragma unroll
            for (int w = 0; w < 8; ++w) sum += red[(w * 17 + bi) * 64 + cc];
            MOD[(size_t)(l * 17 + bi) * 6144 + c0 + cc] = sum + p.ada_b[l * 6144 + c0 + cc];
        }
        __syncthreads();
    }
    {
        float* ROPE = (float*)(p.ws + WS_ROPE);
        for (int u = blockIdx.x; u < 64; u += gridDim.x) {
            const int idx = u * NT + tid, n = idx >> 4, which = (idx >> 3) & 1, j = idx & 7;
            const float inv = 1.0f / powf(10000.f, (float)(2 * j) / 16.f);
            const float pos = which ? (float)(n & 63) : (float)(n >> 6);
            const float ang = pos * inv;
            ROPE[n * 32 + which * 16 + j] = cosf(ang); ROPE[n * 32 + which * 16 + 8 + j] = sinf(ang);
        }
    }
    {
        bf16_t* WIN = (bf16_t*)(p.ws + WS_WIN); const float* w_in = p.w_in;
        tr_stream(1280, [&](int u) {
            const int l = u / 640, rem = u % 640, nt = rem >> 4, kt = rem & 15, n0 = nt * 64, k0 = kt * 64;
            int mode = 0, sc = n0, offA = 0, offB = 32;
            if (n0 >= 512 && n0 < 768) { mode = 1; sc = n0; }
            else if (n0 >= 768 && n0 < 1024) { mode = 2; sc = n0 - 256; }
            else if (n0 >= 1024) { sc = n0 - 256; }
            if (n0 >= C_DQ && n0 < C_DV) {
                const int tb = n0 >= C_DK ? C_DK : C_DQ, p0 = n0 - tb, bj = p0 >> 7, wcA = (p0 >> 5) & 3;
                sc = tb - 256; offA = 64 * wcA + 32 * bj; offB = 64 * (wcA + 1) + 32 * bj;
            }
            return TrJob{w_in + (size_t)l * 1024 * 2304 + (size_t)k0 * 2304 + sc, 2304, WIN + (size_t)l * INW * 1024 + (size_t)n0 * 1024 + k0, 1024, mode, offA, offB};
        }, (LAS float*)smem);
    }
    {
        bf16_t* WOUT = (bf16_t*)(p.ws + WS_WOUT); const float* w_out = p.w_out;
        tr_stream(512, [&](int u) {
            const int l = u >> 8, rem = u & 255, nt = rem >> 4, kt = rem & 15;
            return TrJob{w_out + (size_t)l * 1024 * 1024 + (size_t)kt * 64 * 1024 + nt * 64, 1024, WOUT + (size_t)l * 1024 * 1024 + (size_t)nt * 64 * 1024 + kt * 64, 1024, 0, 0, 32};
        }, (LAS float*)smem);
    }
    {
        bf16_t* D2 = (bf16_t*)(p.ws + WS_DFT2); bf16_t* DC2 = (bf16_t*)(p.ws + WS_DFTC2);
        for (int n = blockIdx.x; n < 2048; n += gridDim.x)
            for (int m = tid; m < 2048; m += NT) {
                const float rev = (float)((n * m) & 2047) * (1.f / 2048.f);
                D2[(size_t)n * 4096 + m] = (bf16_t)f2bf(__builtin_amdgcn_cosf(rev)); D2[(size_t)n * 4096 + 2048 + m] = (bf16_t)f2bf(-__builtin_amdgcn_sinf(rev));
            }
        for (int n = blockIdx.x; n < 256; n += gridDim.x)
            if (tid < 256) {
                const float rev = (float)((n * tid) & 255) * (1.f / 256.f);
                DC2[n * 512 + tid] = (bf16_t)f2bf(__builtin_amdgcn_cosf(rev)); DC2[n * 512 + 256 + tid] = (bf16_t)f2bf(-__builtin_amdgcn_sinf(rev));
            }
    }
    if (blockIdx.x == 0 && tid < 128) {
        const int l = tid >> 6; float* CST = (float*)(p.ws + WS_CONST);
        const float lam_init = l == 0 ? 0.2f : 0.35550906759f;
        const float* dl = p.dlam + l * 128;
        float s1 = lane < 32 ? dl[lane] * dl[32 + lane] : 0.f, s2 = lane < 32 ? dl[64 + lane] * dl[96 + lane] : 0.f;
        s1 = wave_sum(s1); s2 = wave_sum(s2);
        float mq = lane < 32 ? fabsf(p.dqn[l * 32 + lane]) : 0.f, mk = lane < 32 ? fabsf(p.dkn[l * 32 + lane]) : 0.f;
        float nq = fabsf(p.nqn[l * 64 + lane]), nk = fabsf(p.nkn[l * 64 + lane]);
        float mb = 0.f;
        for (int i = lane; i < 4 * 15 * 31; i += 64) mb = fmaxf(mb, p.rpb[l * 4 * 15 * 31 + i]);
#pragma unroll
        for (int o = 1; o < 64; o <<= 1) { mq = fmaxf(mq, __shfl_xor(mq, o)); mk = fmaxf(mk, __shfl_xor(mk, o)); nq = fmaxf(nq, __shfl_xor(nq, o)); nk = fmaxf(nk, __shfl_xor(nk, o)); mb = fmaxf(mb, __shfl_xor(mb, o)); }
        if (lane == 0) {
            CST[l * 8 + 0] = expf(s1) - expf(s2) + lam_init;
            CST[l * 8 + 1] = 5.656854249f * mq * mk * 1.001f;
            CST[l * 8 + 2] = 8.f * nq * nk * 1.001f + mb;
            CST[l * 8 + 3] = 1.f - lam_init;
        }
    }
}

struct WxJob { const float* s; unsigned char* d; int pbase, pmul; };
__device__ __forceinline__ WxJob wx_job(const Params& p, int l, int u) {
    const int mat = u >> 7, e = mat < 32 ? (mat >> 1) : mat - 32, which = mat < 32 ? (mat & 1) : 2, tile = u & 127, kt = tile >> 4, nt = tile & 15;
    const size_t eoff = ((size_t)l * NE + e) * 1024 * 1024 + (size_t)kt * 128 * 1024 + nt * 64;
    const float* src = which == 0 ? p.wg : which == 1 ? p.wu : p.wd;
    WxJob j;
    j.s = src + eoff;
    j.d = (which < 2 ? p.ws + WS_WGU + (size_t)e * 2048 * 1024 : p.ws + WS_WD + (size_t)e * 1024 * 1024) + kt * 128;
    j.pbase = which < 2 ? 2 * nt * 64 + which : nt * 64; j.pmul = which < 2 ? 2 : 1;
    return j;
}
__device__ __forceinline__ void phase_wexp(const Params& p, int l, LAS char* smem, int j0, int j1, int b0, int nb) {
    LAS float* sm = (LAS float*)smem;
    const int njobs = j1;
    const int t = otid();
    const int lk = t >> 4, ln = (t & 15) * 4;
    const int on = t >> 3, ok0 = (t & 7) * 16;
    if ((int)blockIdx.x < b0 || (int)blockIdx.x >= b0 + nb) return;
    int u = j0 + ((int)blockIdx.x - b0);
    if (u >= njobs) return;
    const int u0 = u;
#define WX_LOAD(v, uu) do { const int _u = (uu); const WxJob _j = wx_job(p, l, _u < njobs ? _u : u0); \
        _Pragma("unroll") for (int i = 0; i < 4; ++i) v[i] = *(const f32x4*)(_j.s + (size_t)(lk + 32 * i) * 1024 + ln); } while (0)
#define WX_STEP(v, uu) do { \
        _Pragma("unroll") for (int i = 0; i < 4; ++i) { LAS float* q = sm + (lk + 32 * i) * 65 + ln; q[0] = v[i][0]; q[1] = v[i][1]; q[2] = v[i][2]; q[3] = v[i][3]; } \
        __syncthreads(); \
        WX_LOAD(v, (uu) + 3 * nb); \
        const WxJob jb = wx_job(p, l, (uu)); \
        float o[16]; \
        _Pragma("unroll") for (int i = 0; i < 16; ++i) o[i] = sm[(ok0 + i) * 65 + on]; \
        u32x4 w0; \
        _Pragma("unroll") for (int i = 0; i < 4; ++i) { int q = 0; q = __builtin_amdgcn_cvt_pk_fp8_f32(o[4 * i] * W8_SCALE, o[4 * i + 1] * W8_SCALE, q, false); \
            q = __builtin_amdgcn_cvt_pk_fp8_f32(o[4 * i + 2] * W8_SCALE, o[4 * i + 3] * W8_SCALE, q, true); w0[i] = (unsigned)q; } \
        const int c = jb.pbase + jb.pmul * on, cl = c & 255; \
        const int drow = (c & ~255) + 128 * ((cl >> 3) & 1) + 32 * (cl >> 6) + 8 * ((cl >> 4) & 3) + (cl & 7); \
        *(u32x4*)(jb.d + (size_t)drow * 1024 + ok0) = w0; \
        __syncthreads(); } while (0)
    f32x4 va[4], vb[4], vc[4];
    WX_LOAD(va, u); WX_LOAD(vb, u + nb); WX_LOAD(vc, u + 2 * nb);
    while (true) {
        WX_STEP(va, u); u += nb; if (u >= njobs) break;
        WX_STEP(vb, u); u += nb; if (u >= njobs) break;
        WX_STEP(vc, u); u += nb; if (u >= njobs) break;
    }
#undef WX_LOAD
#undef WX_STEP
}

template <bool XBF>
__device__ __forceinline__ void phase_norm1_t(const Params& p, int l, LAS char* smem) {
    const int tid = otid(), lane = tid & 63, wave = tid >> 6;
    const float* MODl = (const float*)(p.ws + WS_MOD) + (size_t)l * 17 * 6144;
    const float* g = p.norm1_g + l * 1024;
    bf16_t* HX = (bf16_t*)(p.ws + WS_S2);
    const void* xa = XBF ? (const void*)p.out : (const void*)p.x; const void* xb = XBF ? (const void*)(p.ws + WS_XC) : (const void*)p.ctx;
    f32x4 gg[4];
#pragma unroll
    for (int i = 0; i < 4; ++i) gg[i] = *(const f32x4*)(g + i * 256 + lane * 4);
    const int rpb = (NROW + gridDim.x - 1) / gridDim.x, rbeg = blockIdx.x * rpb, rend = min(rbeg + rpb, NROW);
    LAS float* modL = (LAS float*)smem;
    const int re_ = max(rend - 1, 0), bi0 = rbeg < NLAT ? (rbeg >> 11) : 16, bi1 = re_ < NLAT ? (re_ >> 11) : 16;
    __syncthreads();
    for (int i = tid; i < 2 * 512; i += NT) { const int s = i >= 512, k = i - s * 512; *(LAS f32x4*)(modL + s * 2048 + 4 * k) = *(const f32x4*)(MODl + (s ? bi1 : bi0) * 6144 + 4 * k); }
    __syncthreads();
    int r = rbeg + wave;
    XRaw<XBF> nx, nx2;
    if (r < rend) xraw_load<XBF>(nx, xa, xb, r, lane);
    if (r + 8 < rend) xraw_load<XBF>(nx2, xa, xb, r + 8, lane);
    int bic = -1; f32x4 shv[4], scv[4];
    auto body = [&](XRaw<XBF>& bx, const int r) {
        f32x4 v[4];
        xraw_get<XBF>(bx, v);
        xraw_load<XBF>(bx, xa, xb, min(r + 16, rend - 1), lane);
        const int bi = r < NLAT ? (r >> 11) : 16;
        if (bi != bic) { bic = bi;
#pragma unroll
            for (int i = 0; i < 4; ++i) { const LAS float* mb = modL + (bi == bi0 ? 0 : 2048) + i * 256 + lane * 4; shv[i] = *(const LAS f32x4*)mb; scv[i] = *(const LAS f32x4*)(mb + 1024); } }
        float ss = 0.f;
#pragma unroll
        for (int i = 0; i < 4; ++i) ss += v[i][0] * v[i][0] + v[i][1] * v[i][1] + v[i][2] * v[i][2] + v[i][3] * v[i][3];
        ss = wave_sum(ss);
        const float rstd = rsqrtf(ss * (1.f / 1024.f) + EPS);
#pragma unroll
        for (int i = 0; i < 4; ++i) {
            const int col = i * 256 + lane * 4;
            const f32x4 sh = shv[i], sc = scv[i];
            float o[4];
#pragma unroll
            for (int j = 0; j < 4; ++j) o[j] = v[i][j] * rstd * gg[i][j] * (1.f + sc[j]) + sh[j];
            u32x2 w; w.x = pk2(o[0], o[1]); w.y = pk2(o[2], o[3]);
            *(u32x2*)(HX + (size_t)r * 1024 + col) = w;
        }
    };
    for (; r + 8 < rend; r += 16) { body(nx, r); body(nx2, r + 8); }
    if (r < rend) body(nx, r);
    __syncthreads();
}

__device__ __forceinline__ void phase_norm1(const Params& p, int l, LAS char* smem) { if (l == 0) phase_norm1_t<false>(p, l, smem); else phase_norm1_t<true>(p, l, smem); }

template <class Epi>
__device__ __forceinline__ void gemm128(const bf16_t* __restrict__ A, size_t lda, const bf16_t* __restrict__ B, size_t ldb, int K,
                                        const bf16_t* __restrict__ A2, size_t lda2, const bf16_t* __restrict__ B2, size_t ldb2, int K2,
                                        LAS char* smem, const Epi& epi) {
    LAS bf16_t* sA = (LAS bf16_t*)smem; LAS bf16_t* sB = sA + 128 * 40;
    const int tid = otid(), lane = tid & 63, wave = tid >> 6;
    const int lr = tid >> 2, lk = (tid & 3) * 8;
    const int wm = wave >> 2, wn = wave & 3, fr = lane & 15, fq = lane >> 4;
    f32x4 acc[4][2];
#pragma unroll
    for (int i = 0; i < 4; ++i)
#pragma unroll
        for (int j = 0; j < 2; ++j) acc[i][j] = (f32x4){0.f, 0.f, 0.f, 0.f};
    for (int seg = 0; seg < 2; ++seg) {
        const bf16_t* Ap = seg ? A2 : A; const bf16_t* Bp = seg ? B2 : B;
        const size_t la = seg ? lda2 : lda, lb = seg ? ldb2 : ldb; const int Ks = seg ? K2 : K;
        if (Ks == 0) break;
        const bf16_t* ga = Ap + (size_t)lr * la + lk; const bf16_t* gb = Bp + (size_t)lr * lb + lk;
        u32x4 ra = *(const u32x4*)ga, rb = *(const u32x4*)gb;
        const int nk = Ks >> 5;
        for (int kt = 0; kt < nk; ++kt) {
            __syncthreads();
            *(LAS u32x4*)(sA + lr * 40 + lk) = ra; *(LAS u32x4*)(sB + lr * 40 + lk) = rb;
            __syncthreads();
            if (kt + 1 < nk) { ra = *(const u32x4*)(ga + (kt + 1) * 32); rb = *(const u32x4*)(gb + (kt + 1) * 32); }
            bf16x8 af[4], bfr[2];
#pragma unroll
            for (int i = 0; i < 4; ++i) af[i] = *(LAS bf16x8*)(sA + (wm * 64 + i * 16 + fr) * 40 + fq * 8);
#pragma unroll
            for (int j = 0; j < 2; ++j) bfr[j] = *(LAS bf16x8*)(sB + (wn * 32 + j * 16 + fr) * 40 + fq * 8);
#pragma unroll
            for (int i = 0; i < 4; ++i)
#pragma unroll
                for (int j = 0; j < 2; ++j) acc[i][j] = __builtin_amdgcn_mfma_f32_16x16x32_bf16(bfr[j], af[i], acc[i][j], 0, 0, 0);
        }
    }
#pragma unroll
    for (int i = 0; i < 4; ++i)
#pragma unroll
        for (int j = 0; j < 2; ++j) epi(wm * 64 + i * 16 + fr, wn * 32 + j * 16 + fq * 4, acc[i][j]);
    __syncthreads();
}


namespace pg8 {
constexpr int BM = 256, BK = 64, HALF = 128, HTB = HALF * BK * 2, STAGE_BYTES = 8 * HTB, NXCD = 8, WGM = 8;
__host__ __device__ __forceinline__ int lds_byte(int r, int c) { const int st = (r >> 4) * 2 + (c >> 5), rr = r & 15, cc = c & 31, ob = rr * 64 + cc * 2; return st * 1024 + (ob ^ (((ob >> 9) & 1) << 5)); }
__host__ __device__ __forceinline__ void stage_rc(int b, int& R, int& C) { const int st = b / 1024, sb = b % 1024, swz = sb ^ (((sb >> 9) & 1) << 5); R = (st >> 1) * 16 + swz / 64; C = (st & 1) * 32 + (swz % 64) / 2; }
__host__ __device__ __forceinline__ int perm32(int rho) { const int n = rho >> 4, i = rho & 15; return 8 * (i >> 2) + 4 * n + (i & 3); }
struct Unit { int pm, pn; };
struct Gemm { const bf16_t* A; const bf16_t* Bt; int M, N, K; const int* gidx; };
struct StaticOrder {
    int nM, nN, nwg, G, c;
    __host__ __device__ void init(int M, int N, int G_, int c_) { nM = M / BM; nN = N / BM; nwg = nM * nN; G = G_; c = c_; }
    __host__ __device__ bool next(int i, Unit& u) const {
        const long L = (long)i * G + c; if (L >= nwg) return false;
        int wgid = (int)L; { const int q = nwg / NXCD, r = nwg % NXCD, xcd = wgid % NXCD, off = wgid / NXCD; wgid = (xcd < r ? xcd * (q + 1) : r * (q + 1) + (xcd - r) * q) + off; }
        const int nig = WGM * nN, gid = wgid / nig, fm = gid * WGM, gsz = (nM - fm) < WGM ? (nM - fm) : WGM;
        u.pm = fm + ((wgid % nig) % gsz); u.pn = (wgid % nig) / gsz; return true;
    }
    __device__ __forceinline__ void a_ready(const Unit&) const {}
    __device__ __forceinline__ void done(const Unit&) const {}
};
struct ExpertOrder {
    int mt_e, nN, G, c;
    __device__ bool next(int i, Unit& u) const {
        const long L = (long)i * G + c; const int per_e = mt_e * nN; if (L >= (long)NE * per_e) return false;
        const int x = (int)(L & 7), q = (int)(L >> 3), rt = x + 8 * (q / nN), pn_l = q % nN, e = rt / mt_e, pm_l = rt % mt_e;
        u.pm = e * (MEST / 256) + pm_l; u.pn = e * nN + pn_l; return true;
    }
    __device__ __forceinline__ void a_ready(const Unit&) const {}
    __device__ __forceinline__ void done(const Unit&) const {}
};
struct FourierOrder {
    int nM, G, c;
    __device__ bool next(int i, Unit& u) const { const long L = (long)i * G + c; if (L >= (long)nM * NB) return false; u.pm = (int)L % nM; u.pn = (int)L / nM; return true; }
    __device__ __forceinline__ void a_ready(const Unit&) const {}
    __device__ __forceinline__ void done(const Unit&) const {}
};
typedef float f32x2_t __attribute__((ext_vector_type(2)));
typedef __bf16 bf16x2_t __attribute__((ext_vector_type(2)));
__device__ __forceinline__ unsigned cvt_pk_bf16(float lo, float hi) { const f32x2_t v = {lo, hi}; return __builtin_bit_cast(unsigned, __builtin_convertvector(v, bf16x2_t)); }

typedef int v8i_t __attribute__((ext_vector_type(8)));
template <class Epi, class Sched, bool GATHER = false, bool FP8 = false, int SCALE_W = 127, int SCALE_A = 127>
__device__ __forceinline__ void gemm_phase(LAS unsigned char* lds, const Gemm g, const Sched& S, const Epi& E) {
    const int tid = otid(), wid = __builtin_amdgcn_readfirstlane(tid >> 6), lane = tid & 63, wr = wid >> 2, wc = wid & 3, fr = lane & 15, fq = lane >> 4;
    const int K = g.K, Kb = FP8 ? K : 2 * K  , nt = Kb / (BK * 2);
    unsigned voffA[2], voffB[2], gC2[2]; int gR[2];
#pragma unroll
    for (int i = 0; i < 2; ++i) { int R, C; stage_rc(tid * 16 + i * 8192, R, C); const int Rb = Epi::PERM ? ((R & ~31) + perm32(R & 31)) : R;
        voffA[i] = (unsigned)(R * Kb + C * 2); voffB[i] = (unsigned)(Rb * Kb + C * 2); gR[i] = R; gC2[i] = (unsigned)C * 2u; }
    const size_t kstep = (size_t)(BK * 2);
    const size_t hstep = (size_t)HALF * Kb;
    const size_t tstep = 2 * hstep;
    const unsigned ldsw = (unsigned)wid * 1024u;
    const int aoff = lds_byte(wr * 64 + fr, fq * 8), boff = lds_byte(wc * 32 + fr, fq * 8);
#define PG8_SA(b, h) (((b) * 2 + (h)) * HTB)
#define PG8_SB(b, h) ((4 + (b) * 2 + (h)) * HTB)
#define PG8_STAGE(bufoff, gbase, voff) do { _Pragma("unroll") for (int _i = 0; _i < 2; ++_i) \
        __builtin_amdgcn_global_load_lds((const unsigned*)((const char*)(gbase) + (voff)[_i]), (LAS unsigned*)(lds + (bufoff) + ldsw + _i * 8192), 16, 0, 0); } while (0)
#define PG8_LD8(ptr_) ({ const u32x4 _l = *(const LAS u32x4*)(ptr_), _h = *(const LAS u32x4*)((ptr_) + 1024); (v8i_t){(int)_l.x, (int)_l.y, (int)_l.z, (int)_l.w, (int)_h.x, (int)_h.y, (int)_h.z, (int)_h.w}; })
#define PG8_LDA(dst, b, h) do { _Pragma("unroll") for (int m = 0; m < 4; ++m) { if constexpr (FP8) dst##8[m] = PG8_LD8(lds + PG8_SA(b, h) + aoff + m * 2048); \
        else { _Pragma("unroll") for (int k = 0; k < 2; ++k) dst[m][k] = *(const LAS bf16x8*)(lds + PG8_SA(b, h) + aoff + m * 2048 + k * 1024); } } } while (0)
#define PG8_LDB(dst, b, h) do { _Pragma("unroll") for (int n = 0; n < 2; ++n) { if constexpr (FP8) dst##8[n] = PG8_LD8(lds + PG8_SB(b, h) + boff + n * 2048); \
        else { _Pragma("unroll") for (int k = 0; k < 2; ++k) dst[n][k] = *(const LAS bf16x8*)(lds + PG8_SB(b, h) + boff + n * 2048 + k * 1024); } } } while (0)
#define PG8_MMA(ai, bj, At, Bt) do { __builtin_amdgcn_s_setprio(1); _Pragma("unroll") for (int m = 0; m < 4; ++m) _Pragma("unroll") for (int n = 0; n < 2; ++n) { \
        if constexpr (FP8) {   \
            asm volatile("v_mfma_scale_f32_16x16x128_f8f6f4 %0, %1, %2, %0, %3, %4 op_sel_hi:[0,0,0]" : "+v"(acc[ai][bj][m][n]) : "v"(Bt##8[n]), "v"(At##8[m]), "v"(scw), "v"(sca)); } \
        else { _Pragma("unroll") for (int k = 0; k < 2; ++k) acc[ai][bj][m][n] = __builtin_amdgcn_mfma_f32_16x16x32_bf16(Bt[n][k], At[m][k], acc[ai][bj][m][n], 0, 0, 0); } } \
        __builtin_amdgcn_s_setprio(0); } while (0)
#define PG8_WAIT_V(n) asm volatile("s_waitcnt vmcnt(" #n ")" ::: "memory")
#define PG8_WAIT_L(n) asm volatile("s_waitcnt lgkmcnt(" #n ")" ::: "memory")
#define PG8_BAR __builtin_amdgcn_s_barrier()
#define PG8_SCHED __builtin_amdgcn_sched_barrier(0)
    unsigned go00 = 0, go01 = 0, go10 = 0, go11 = 0, gn00 = 0, gn01 = 0, gn10 = 0, gn11 = 0;
#define PG8_GOFF(u, o00, o01, o10, o11) do { const int* _ix = g.gidx + (size_t)(u).pm * BM; \
        o00 = (unsigned)_ix[gR[0]] * (unsigned)Kb + gC2[0]; o01 = (unsigned)_ix[gR[1]] * (unsigned)Kb + gC2[1]; \
        o10 = (unsigned)_ix[HALF + gR[0]] * (unsigned)Kb + gC2[0]; o11 = (unsigned)_ix[HALF + gR[1]] * (unsigned)Kb + gC2[1]; } while (0)
#define PG8_STAGE_A(bufoff, plainptr, kt, h, nx) do { if constexpr (GATHER) { unsigned _vo[2]; \
            _vo[0] = (nx) ? ((h) ? gn10 : gn00) : ((h) ? go10 : go00); _vo[1] = (nx) ? ((h) ? gn11 : gn01) : ((h) ? go11 : go01); \
            PG8_STAGE(bufoff, (const char*)g.A + (size_t)(kt) * kstep, _vo); } else { PG8_STAGE(bufoff, plainptr, voffA); } } while (0)
    Unit cur, nxt; int ui = 0;
    if (!S.next(0, cur)) return;
    int scw = SCALE_W * 0x01010101, sca = SCALE_A * 0x01010101;
    asm volatile("" : "+v"(scw), "+v"(sca));
    f32x4 acc[2][2][4][2];
#pragma unroll
    for (int a = 0; a < 2; ++a)
#pragma unroll
        for (int b = 0; b < 2; ++b)
#pragma unroll
            for (int m = 0; m < 4; ++m)
#pragma unroll
                for (int n = 0; n < 2; ++n) acc[a][b][m][n] = (f32x4){0.f, 0.f, 0.f, 0.f};
    bf16x8 At[FP8 ? 1 : 4][2], B0[FP8 ? 1 : 2][2], B1[FP8 ? 1 : 2][2];
    v8i_t At8[FP8 ? 4 : 1], B08[FP8 ? 2 : 1], B18[FP8 ? 2 : 1];
    const char* cA = (const char*)g.A + (size_t)cur.pm * tstep; const char* cB = (const char*)g.Bt + (size_t)cur.pn * tstep;
    S.a_ready(cur);
    if constexpr (GATHER) PG8_GOFF(cur, go00, go01, go10, go11);
    PG8_STAGE(PG8_SB(0, 0), cB, voffB); PG8_STAGE_A(PG8_SA(0, 0), cA, 0, 0, false); PG8_STAGE(PG8_SB(0, 1), cB + hstep, voffB); PG8_STAGE_A(PG8_SA(0, 1), cA + hstep, 0, 1, false);
    if (wr == 1) PG8_BAR;
    PG8_WAIT_V(4); PG8_BAR;
    PG8_STAGE(PG8_SB(1, 0), cB + kstep, voffB); PG8_STAGE_A(PG8_SA(1, 0), cA + kstep, 1, 0, false); PG8_STAGE(PG8_SB(1, 1), cB + hstep + kstep, voffB);
    PG8_WAIT_V(6); PG8_BAR;
    for (;;) {
        const bool has_next = S.next(ui + 1, nxt);
        if constexpr (GATHER) { if (has_next) PG8_GOFF(nxt, gn00, gn01, gn10, gn11); else { gn00 = go00; gn01 = go01; gn10 = go10; gn11 = go11; } }
        const char* nA = has_next ? (const char*)g.A + (size_t)nxt.pm * tstep : cA; const char* nB = has_next ? (const char*)g.Bt + (size_t)nxt.pn * tstep : cB;
#pragma unroll 1
        for (int t = 0; t < nt; t += 2) {
            const bool last = (t == nt - 2);
            const char* a1 = cA + (size_t)(t + 1) * kstep;
            const char* a2 = last ? nA : cA + (size_t)(t + 2) * kstep; const char* b2 = last ? nB : cB + (size_t)(t + 2) * kstep;
            const char* a3 = a2 + kstep; const char* b3 = b2 + kstep;
            if (last && has_next) S.a_ready(nxt);
            PG8_LDB(B0, 0, 0); PG8_SCHED; PG8_LDA(At, 0, 0); PG8_STAGE_A(PG8_SA(1, 1), a1 + hstep, t + 1, 1, false);
            PG8_WAIT_L(8); PG8_BAR; PG8_WAIT_L(0); PG8_MMA(0, 0, At, B0); PG8_BAR; PG8_SCHED;
            PG8_LDB(B1, 0, 1); PG8_STAGE(PG8_SB(0, 0), b2, voffB);
            PG8_BAR; PG8_WAIT_L(0); PG8_MMA(0, 1, At, B1); PG8_BAR;
            PG8_LDA(At, 0, 1); PG8_STAGE_A(PG8_SA(0, 0), a2, (last ? 0 : t + 2), 0, last);
            PG8_BAR; PG8_WAIT_L(0); PG8_MMA(1, 0, At, B0); PG8_BAR; PG8_SCHED;
            PG8_STAGE(PG8_SB(0, 1), b2 + hstep, voffB);
            PG8_WAIT_V(6); PG8_BAR; PG8_MMA(1, 1, At, B1); PG8_BAR;
            PG8_LDB(B0, 1, 0); PG8_SCHED; PG8_LDA(At, 1, 0); PG8_STAGE_A(PG8_SA(0, 1), a2 + hstep, (last ? 0 : t + 2), 1, last);
            PG8_WAIT_L(8); PG8_BAR; PG8_WAIT_L(0); PG8_MMA(0, 0, At, B0); PG8_BAR; PG8_SCHED;
            PG8_LDB(B1, 1, 1); PG8_STAGE(PG8_SB(1, 0), b3, voffB);
            PG8_BAR; PG8_WAIT_L(0); PG8_MMA(0, 1, At, B1); PG8_BAR;
            PG8_LDA(At, 1, 1); PG8_STAGE_A(PG8_SA(1, 0), a3, (last ? 1 : t + 3), 0, last);
            PG8_BAR; PG8_WAIT_L(0); PG8_MMA(1, 0, At, B0); PG8_BAR; PG8_SCHED;
            PG8_STAGE(PG8_SB(1, 1), b3 + hstep, voffB);
            PG8_WAIT_V(6); PG8_BAR; PG8_MMA(1, 1, At, B1); PG8_BAR;
        }
        if constexpr (FP8) asm volatile("s_nop 15\n\ts_nop 15" ::: "memory");
        E(acc, cur, wr, wc, fr, fq); S.done(cur);
        if (!has_next) break;
#pragma unroll
        for (int a = 0; a < 2; ++a)
#pragma unroll
            for (int b = 0; b < 2; ++b)
#pragma unroll
                for (int m = 0; m < 4; ++m)
#pragma unroll
                    for (int n = 0; n < 2; ++n) acc[a][b][m][n] = (f32x4){0.f, 0.f, 0.f, 0.f};
        cur = nxt; cA = nA; cB = nB; ++ui; go00 = gn00; go01 = gn01; go10 = gn10; go11 = gn11;
    }
    PG8_WAIT_V(0);
    if (wr == 0) PG8_BAR;
    PG8_BAR;
#undef PG8_SA
#undef PG8_SB
#undef PG8_STAGE
#undef PG8_LDA
#undef PG8_LD8
#undef PG8_LDB
#undef PG8_MMA
#undef PG8_WAIT_V
#undef PG8_WAIT_L
#undef PG8_BAR
#undef PG8_SCHED
#undef PG8_GOFF
#undef PG8_STAGE_A
}

struct EpiInproj {
    static constexpr bool PERM = true, AFTER_DRAIN = false;
    bf16_t* PX; bf16_t* ZT2; bf16_t* VT; bf16_t* VTD; const LAS float* gl;
    __device__ __forceinline__ void operator()(const f32x4 (&acc)[2][2][4][2], const Unit& u, int wr, int wc, int fr, int fq) const {
        const int row0 = u.pm * BM + wr * 64 + fr, col0 = u.pn * BM + wc * 32 + 8 * fq;
        if (u.pn == 2 || u.pn == 3 || u.pn == 6 || u.pn == 9) {
            const bool lat = u.pm < NLAT / 256;
            const int ch0 = wc * 32 + 8 * fq;
            int cstride, bstep = HALF; size_t base0; bf16_t* bp;
            if (u.pn == 6 || u.pn == 9) {
                cstride = lat ? 2048 : 256;
                if (lat) base0 = (size_t)(u.pm >> 3) * 256 * 2048 + ((u.pm & 7) * 256 + wr * 64 + fr) + (size_t)ch0 * 2048;
                else base0 = VT_CTX_OFF + (size_t)(u.pm - NLAT / 256) * 256 * 256 + (wr * 64 + fr) + (size_t)ch0 * 256;
                bp = VT + base0; if (u.pn == 9) bp = VTD + base0;
            } else {
                const int zr0 = 128 * (wc & 1) + 32 * (wc >> 1) + 8 * fq;
                bstep = 64;
                cstride = lat ? 4096 : 512;
                if (lat) base0 = (size_t)(u.pm >> 3) * 256 * 4096 + (u.pn == 3 ? 2048 : 0) + ((u.pm & 7) * 256 + wr * 64 + fr) + (size_t)zr0 * 4096;
                else base0 = (size_t)NB * 256 * 4096 + (size_t)(u.pm - NLAT / 256) * 256 * 512 + (u.pn == 3 ? 256 : 0) + (wr * 64 + fr) + (size_t)zr0 * 512;
                bp = ZT2 + base0;
            }
#pragma unroll
            for (int bj = 0; bj < 2; ++bj)
#pragma unroll
                for (int n = 0; n < 2; ++n) {
#pragma unroll
                    for (int j = 0; j < 4; ++j) {
                        bf16_t* cp = bp + (size_t)((bj * bstep + 4 * n + j) * cstride);
#pragma unroll
                        for (int ai = 0; ai < 2; ++ai)
#pragma unroll
                            for (int m = 0; m < 4; ++m) cp[ai * HALF + m * 16] = (bf16_t)f2bf(acc[ai][bj][m][n][j]);
                    }
                    asm volatile("" ::: "memory");
                }
        } else if (u.pn == 4 || u.pn == 5) {
            const bool isq = u.pn == 4, lat = u.pm < NLAT / 256;
            const LAS float* gsrc = gl + (isq ? 0 : 32) + 8 * fq;
            const f32x4 g0 = *(const LAS f32x4*)gsrc, g1 = *(const LAS f32x4*)(gsrc + 4);
            const float qs = isq ? 0.25503486164919736f : 1.f;
            const int tok0 = row0 & 2047;
#pragma unroll
            for (int ai = 0; ai < 2; ++ai)
#pragma unroll
                for (int m = 0; m < 4; ++m) {
                    const int row = row0 + ai * HALF + m * 16;
                    f32x4 c0 = (f32x4){1.f, 1.f, 1.f, 1.f}, c1 = c0, s0 = (f32x4){0.f, 0.f, 0.f, 0.f}, s1 = s0;
                    if (lat) {
                        const int tok = tok0 + ai * HALF + m * 16;
                        const float pos = (float)((fq & 2) ? (tok & 63) : (tok >> 6));
                        const float sg = (fq & 1) ? 1.f : -1.f;
                        const float a0 = pos * 0.15915494309189535f, a1 = pos * 0.05032921210448704f, a2 = pos * 0.015915494309189534f, a3 = pos * 0.005032921210448704f;
                        const float a4 = pos * 0.0015915494309189536f, a5 = pos * 0.0005032921210448704f, a6 = pos * 0.00015915494309189535f, a7 = pos * 0.00005032921210448704f;
                        c0 = (f32x4){__builtin_amdgcn_cosf(a0), __builtin_amdgcn_cosf(a1), __builtin_amdgcn_cosf(a2), __builtin_amdgcn_cosf(a3)};
                        c1 = (f32x4){__builtin_amdgcn_cosf(a4), __builtin_amdgcn_cosf(a5), __builtin_amdgcn_cosf(a6), __builtin_amdgcn_cosf(a7)};
                        s0 = (f32x4){__builtin_amdgcn_sinf(a0), __builtin_amdgcn_sinf(a1), __builtin_amdgcn_sinf(a2), __builtin_amdgcn_sinf(a3)} * sg;
                        s1 = (f32x4){__builtin_amdgcn_sinf(a4), __builtin_amdgcn_sinf(a5), __builtin_amdgcn_sinf(a6), __builtin_amdgcn_sinf(a7)} * sg;
                    }
#pragma unroll
                    for (int bj = 0; bj < 2; ++bj) {
                        f32x4 v0 = acc[ai][bj][m][0], v1 = acc[ai][bj][m][1];
                        float ss = (v0[0] * v0[0] + v0[1] * v0[1]) + (v0[2] * v0[2] + v0[3] * v0[3]) + (v1[0] * v1[0] + v1[1] * v1[1]) + (v1[2] * v1[2] + v1[3] * v1[3]);
                        ss += __shfl_xor(ss, 16); ss += __shfl_xor(ss, 32);
                        const float rs = rsqrtf(ss * (1.f / 32.f) + EPS) * qs;
                        v0 = v0 * rs * g0; v1 = v1 * rs * g1;
                        if (lat) {
                            f32x4 p0, p1;
#pragma unroll
                            for (int j = 0; j < 4; ++j) { p0[j] = __shfl_xor(v0[j], 16); p1[j] = __shfl_xor(v1[j], 16); }
                            v0 = v0 * c0 + p0 * s0; v1 = v1 * c1 + p1 * s1;
                        }
                        u32x4 w; w.x = cvt_pk_bf16(v0[0], v0[1]); w.y = cvt_pk_bf16(v0[2], v0[3]); w.z = cvt_pk_bf16(v1[0], v1[1]); w.w = cvt_pk_bf16(v1[2], v1[3]);
                        *(u32x4*)(PX + (size_t)row * INW + col0 + bj * HALF) = w;
                    }
                }
        } else if (u.pn == 7 || u.pn == 8) {
            const bool isq = u.pn == 7;
            const LAS float* gsrc = gl + (isq ? 64 : 128) + 8 * fq;
            const f32x4 g00 = *(const LAS f32x4*)gsrc, g01 = *(const LAS f32x4*)(gsrc + 4), g10 = *(const LAS f32x4*)(gsrc + 32), g11 = *(const LAS f32x4*)(gsrc + 36);
            const float qs = isq ? 0.18033688011112042f : 1.f;
            const int lcol0 = u.pn * BM + wc * 64 + 8 * fq;
#pragma unroll
            for (int ai = 0; ai < 2; ++ai)
#pragma unroll
                for (int m = 0; m < 4; ++m) {
                    const f32x4 a0 = acc[ai][0][m][0], a1 = acc[ai][0][m][1], b0 = acc[ai][1][m][0], b1 = acc[ai][1][m][1];
                    float ss = ((a0[0] * a0[0] + a0[1] * a0[1]) + (a0[2] * a0[2] + a0[3] * a0[3]) + (a1[0] * a1[0] + a1[1] * a1[1]) + (a1[2] * a1[2] + a1[3] * a1[3]))
                             + ((b0[0] * b0[0] + b0[1] * b0[1]) + (b0[2] * b0[2] + b0[3] * b0[3]) + (b1[0] * b1[0] + b1[1] * b1[1]) + (b1[2] * b1[2] + b1[3] * b1[3]));
                    ss += __shfl_xor(ss, 16); ss += __shfl_xor(ss, 32);
                    const float rs = rsqrtf(ss * (1.f / 64.f) + EPS) * qs;
                    bf16_t* rowp = PX + (size_t)(row0 + ai * HALF + m * 16) * INW + lcol0;
                    { const f32x4 v0 = a0 * rs * g00, v1 = a1 * rs * g01;
                      u32x4 w; w.x = cvt_pk_bf16(v0[0], v0[1]); w.y = cvt_pk_bf16(v0[2], v0[3]); w.z = cvt_pk_bf16(v1[0], v1[1]); w.w = cvt_pk_bf16(v1[2], v1[3]); *(u32x4*)rowp = w; }
                    { const f32x4 v0 = b0 * rs * g10, v1 = b1 * rs * g11;
                      u32x4 w; w.x = cvt_pk_bf16(v0[0], v0[1]); w.y = cvt_pk_bf16(v0[2], v0[3]); w.z = cvt_pk_bf16(v1[0], v1[1]); w.w = cvt_pk_bf16(v1[2], v1[3]); *(u32x4*)(rowp + 32) = w; }
                }
        } else {
#pragma unroll
            for (int ai = 0; ai < 2; ++ai)
#pragma unroll
                for (int m = 0; m < 4; ++m) { bf16_t* rowp = PX + (size_t)(row0 + ai * HALF + m * 16) * INW + col0;
#pragma unroll
                    for (int bj = 0; bj < 2; ++bj) { const f32x4 v0 = acc[ai][bj][m][0], v1 = acc[ai][bj][m][1];
                        u32x4 w; w.x = cvt_pk_bf16(v0[0], v0[1]); w.y = cvt_pk_bf16(v0[2], v0[3]); w.z = cvt_pk_bf16(v1[0], v1[1]); w.w = cvt_pk_bf16(v1[2], v1[3]);
                        *(u32x4*)(rowp + bj * HALF) = w; } }
        }
    }
};
struct EpiFourier {
    static constexpr bool PERM = true, AFTER_DRAIN = false;
    bf16_t* Y; int rowbase, rows_per_b; float scale; const LAS float* hg;
    __device__ __forceinline__ void operator()(const f32x4 (&acc)[2][2][4][2], const Unit& u, int wr, int wc, int fr, int fq) const {
        const int row0 = rowbase + u.pn * rows_per_b + u.pm * BM + wr * 64 + fr, col0 = wc * 64 + 8 * fq;
        f32x4 gv[2][2];
#pragma unroll
        for (int bj = 0; bj < 2; ++bj)
#pragma unroll
            for (int n = 0; n < 2; ++n) gv[bj][n] = *(const LAS f32x4*)(hg + col0 + 32 * bj + 4 * n);
#pragma unroll
        for (int ai = 0; ai < 2; ++ai)
#pragma unroll
            for (int m = 0; m < 4; ++m) {
                float ss = 0.f;
#pragma unroll
                for (int bj = 0; bj < 2; ++bj)
#pragma unroll
                    for (int n = 0; n < 2; ++n) { const f32x4 v = acc[ai][bj][m][n] * scale; ss += (v[0] * v[0] + v[1] * v[1]) + (v[2] * v[2] + v[3] * v[3]); }
                ss += __shfl_xor(ss, 16); ss += __shfl_xor(ss, 32);
                const float rs = rsqrtf(ss * (1.f / 64.f) + EPS) * scale;
                bf16_t* rowp = Y + (size_t)(row0 + ai * HALF + m * 16) * 1024 + 256 + col0;
#pragma unroll
                for (int bj = 0; bj < 2; ++bj) { const f32x4 v0 = acc[ai][bj][m][0] * rs * gv[bj][0], v1 = acc[ai][bj][m][1] * rs * gv[bj][1];
                    u32x4 w; w.x = cvt_pk_bf16(v0[0], v0[1]); w.y = cvt_pk_bf16(v0[2], v0[3]); w.z = cvt_pk_bf16(v1[0], v1[1]); w.w = cvt_pk_bf16(v1[2], v1[3]);
                    *(u32x4*)(rowp + bj * 32) = w; } }
    }
};
struct EpiOutY {
    static constexpr bool PERM = true, AFTER_DRAIN = false;
    bf16_t* YP;
    __device__ __forceinline__ void operator()(const f32x4 (&acc)[2][2][4][2], const Unit& u, int wr, int wc, int fr, int fq) const {
        const int row0 = u.pm * BM + wr * 64 + fr, col0 = u.pn * BM + wc * 32 + 8 * fq;
#pragma unroll
        for (int ai = 0; ai < 2; ++ai)
#pragma unroll
            for (int m = 0; m < 4; ++m) { bf16_t* rowp = YP + (size_t)(row0 + ai * HALF + m * 16) * 1024 + col0;
#pragma unroll
                for (int bj = 0; bj < 2; ++bj) { const f32x4 v0 = acc[ai][bj][m][0], v1 = acc[ai][bj][m][1];
                    u32x4 w; w.x = cvt_pk_bf16(v0[0], v0[1]); w.y = cvt_pk_bf16(v0[2], v0[3]); w.z = cvt_pk_bf16(v1[0], v1[1]); w.w = cvt_pk_bf16(v1[2], v1[3]);
                    *(u32x4*)(rowp + bj * HALF) = w; } }
    }
};
struct EpiSwiglu {
    static constexpr bool PERM = true, AFTER_DRAIN = false;
    unsigned char* HID;
    __device__ __forceinline__ void operator()(const f32x4 (&acc)[2][2][4][2], const Unit& u, int wr, int wc, int fr, int fq) const {
        const int row0 = u.pm * BM + wr * 64 + fr, f00 = ((u.pn & 7) * BM + wc * 64 + 16 * fq) >> 1;
#pragma unroll
        for (int ai = 0; ai < 2; ++ai)
#pragma unroll
            for (int m = 0; m < 4; ++m) {
                u32x2 w;
#pragma unroll
                for (int bj = 0; bj < 2; ++bj) { const f32x4 v0 = acc[ai][bj][m][0], v1 = acc[ai][bj][m][1]; int q = 0;
                    q = __builtin_amdgcn_cvt_pk_fp8_f32(silu_fast(v0[0]) * v0[1] * HID8_SCALE, silu_fast(v0[2]) * v0[3] * HID8_SCALE, q, false);
                    q = __builtin_amdgcn_cvt_pk_fp8_f32(silu_fast(v1[0]) * v1[1] * HID8_SCALE, silu_fast(v1[2]) * v1[3] * HID8_SCALE, q, true); w[bj] = (unsigned)q; }
                *(u32x2*)(HID + (size_t)(row0 + ai * HALF + m * 16) * 1024 + f00) = w;
                __builtin_amdgcn_sched_barrier(0);
            }
    }
};
constexpr float O_SCALE = 8.f;
struct EpiDown {
    static constexpr bool PERM = true, AFTER_DRAIN = false;
    unsigned char* O;
    __device__ __forceinline__ void operator()(const f32x4 (&acc)[2][2][4][2], const Unit& u, int wr, int wc, int fr, int fq) const {
        const int row0 = u.pm * BM + wr * 64 + fr, col0 = (u.pn & 3) * BM + wc * 64 + 16 * fq;
#pragma unroll
        for (int ai = 0; ai < 2; ++ai)
#pragma unroll
            for (int m = 0; m < 4; ++m) {
                u32x4 w;
#pragma unroll
                for (int bj = 0; bj < 2; ++bj)
#pragma unroll
                    for (int n = 0; n < 2; ++n) { const f32x4 v = acc[ai][bj][m][n] * O_SCALE; int q = 0;
                        q = __builtin_amdgcn_cvt_pk_fp8_f32(v[0], v[1], q, false); q = __builtin_amdgcn_cvt_pk_fp8_f32(v[2], v[3], q, true); w[bj * 2 + n] = (unsigned)q; }
                *(u32x4*)(O + (size_t)(row0 + ai * HALF + m * 16) * 1024 + col0) = w;
            }
    }
};
}

__device__ __forceinline__ void phase_inproj(const Params& p, int l, LAS char* smem) {
    pg8::Gemm g{(const bf16_t*)(p.ws + WS_S2), (const bf16_t*)(p.ws + WS_WIN) + (size_t)l * INW * 1024, NROW, INW, 1024, nullptr};
    pg8::StaticOrder S; S.init(NROW, INW, gridDim.x, blockIdx.x);
    { LAS float* gl = (LAS float*)(smem + LDS_EXTRA); const int t = otid();
      if (t < 32) gl[t] = p.dqn[l * 32 + t]; else if (t < 64) gl[t] = p.dkn[l * 32 + t - 32]; else if (t < 128) gl[t] = p.nqn[l * 64 + t - 64]; else if (t < 192) gl[t] = p.nkn[l * 64 + t - 128];
      __syncthreads(); }
    pg8::EpiInproj E{(bf16_t*)(p.ws + WS_S1), (bf16_t*)(p.ws + WS_ZT), (bf16_t*)(p.ws + WS_VT), (bf16_t*)(p.ws + WS_VTD), (const LAS float*)(smem + LDS_EXTRA)};
    pg8::gemm_phase(( LAS unsigned char*)smem, g, S, E);
}

__device__ __forceinline__ void phase_qkprep(const Params& p, int l) {
    const int tid = otid(), lane = tid & 63, wave = tid >> 6;
    bf16_t* PX = (bf16_t*)(p.ws + WS_S1);
    const float* ROPE = (const float*)(p.ws + WS_ROPE);
    const int stride = gridDim.x * 8;
    int r = blockIdx.x * 8 + wave;
    u32x2 nraw[4];
    if (r < NROW) { const bf16_t* row = PX + (size_t)r * INW + lane * 4;
        nraw[0] = *(const u32x2*)(row + C_CQ); nraw[1] = *(const u32x2*)(row + C_CK); nraw[2] = *(const u32x2*)(row + C_DQ); nraw[3] = *(const u32x2*)(row + C_DK); }
    for (; r < NROW; r += stride) {
        bf16_t* row = PX + (size_t)r * INW;
        u32x2 craw[4];
#pragma unroll
        for (int i = 0; i < 4; ++i) craw[i] = nraw[i];
        if (r + stride < NROW) { const bf16_t* rown = PX + (size_t)(r + stride) * INW + lane * 4;
            nraw[0] = *(const u32x2*)(rown + C_CQ); nraw[1] = *(const u32x2*)(rown + C_CK); nraw[2] = *(const u32x2*)(rown + C_DQ); nraw[3] = *(const u32x2*)(rown + C_DK); }
        const bool lat = r < NLAT; const int n = r & 2047;
#pragma unroll
        for (int s = 0; s < 2; ++s) {
            bf16_t* pp = row + C_CQ + s * 256 + lane * 4;
            const u32x2 raw = craw[s];
            float v[4] = {bflo(raw.x), bfhi(raw.x), bflo(raw.y), bfhi(raw.y)};
            float ss = v[0] * v[0] + v[1] * v[1] + v[2] * v[2] + v[3] * v[3];
            ss += __shfl_xor(ss, 1); ss += __shfl_xor(ss, 2); ss += __shfl_xor(ss, 4);
            const float rstd = rsqrtf(ss * (1.f / 32.f) + EPS);
            const float* g = (s ? p.dkn : p.dqn) + l * 32 + (lane & 7) * 4;
            const float qs = s ? 1.f : 0.25503486164919736f;
#pragma unroll
            for (int i = 0; i < 4; ++i) v[i] = v[i] * (rstd * qs) * g[i];
            if (lat) {
                const int half = (lane >> 2) & 1, sub = lane & 3, j0 = (sub & 1) * 4;
                const float* tab = ROPE + n * 32 + half * 16;
#pragma unroll
                for (int i = 0; i < 4; ++i) {
                    const float partner = __shfl_xor(v[i], 2);
                    const float cs = tab[j0 + i], sn = tab[8 + j0 + i];
                    v[i] = (sub & 2) ? (v[i] * cs + partner * sn) : (v[i] * cs - partner * sn);
                }
            }
            u32x2 w; w.x = pk2(v[0], v[1]); w.y = pk2(v[2], v[3]);
            *(u32x2*)pp = w;
        }
#pragma unroll
        for (int s = 0; s < 2; ++s) {
            bf16_t* pp = row + C_DQ + s * 256 + lane * 4;
            const u32x2 raw = craw[2 + s];
            float v[4] = {bflo(raw.x), bfhi(raw.x), bflo(raw.y), bfhi(raw.y)};
            float ss = v[0] * v[0] + v[1] * v[1] + v[2] * v[2] + v[3] * v[3];
            ss += __shfl_xor(ss, 1); ss += __shfl_xor(ss, 2); ss += __shfl_xor(ss, 4); ss += __shfl_xor(ss, 8);
            const float rstd = rsqrtf(ss * (1.f / 64.f) + EPS);
            const float* g = (s ? p.nkn : p.nqn) + l * 64 + (lane & 15) * 4;
            const float rq = rstd * (s ? 1.f : 0.18033688011112042f);
            u32x2 w; w.x = pk2(v[0] * rq * g[0], v[1] * rq * g[1]); w.y = pk2(v[2] * rq * g[2], v[3] * rq * g[3]);
            *(u32x2*)pp = w;
        }
    }
}

__device__ __forceinline__ void phase_sgu(const Params& p, int l, int nu, LAS char* smem) {
    const int tid = otid(), lane = tid & 63, wave = tid >> 6, fr = lane & 15, g = lane >> 4;
    const bf16_t* PX = (const bf16_t*)(p.ws + WS_S1);
    bf16_t* Y = (bf16_t*)(p.ws + WS_S2) + (size_t)NROW * 1024;
    constexpr int VS = 272;
    const int q = tid >> 2, part = tid & 3, pp = wave * 16 + fr;
    int u = blockIdx.x, ustride = gridDim.x, uend = nu;
    if (gridDim.x == 256) {
        const int na = (l == 0) ? 3 : 2, c = blockIdx.x;
        ustride = 128;
        if (c < 128) { u = c; uend = 128 * na; } else { u = 128 * na + (c - 128); uend = nu; }
    }
    if (u >= uend) return;
    auto decode = [&](int unit, int& r0, int& h) {
        if (unit < 1024) { const int b = unit >> 6, ch = (unit >> 2) & 15; h = unit & 3; r0 = b * 2048 + ch * 128; }
        else { const int u2 = unit - 1024, b = u2 >> 3, ch = (u2 >> 2) & 1; h = u2 & 3; r0 = NLAT + b * 256 + ch * 128; }
    };
    int r0, h; decode(u, r0, h);
    bf16x8 wf[4]; float bs; f32x4 gv[4]; int hw = -1;
    u32x4 va, vb; u32x2 uu[4];
#define SGU_LOADROWS(r0_, h_, va_, vb_, uu_) do { const bf16_t* _s = PX + (size_t)((r0_) + q) * INW + C_AV + (h_) * 64 + part * 16; va_ = *(const u32x4*)_s; vb_ = *(const u32x4*)(_s + 8); \
        const bf16_t* _us = PX + (size_t)((r0_) + pp) * INW + C_AU + (h_) * 64 + 4 * g; _Pragma("unroll") for (int ct = 0; ct < 4; ++ct) uu_[ct] = *(const u32x2*)(_us + ct * 16); } while (0)
    SGU_LOADROWS(r0, h, va, vb, uu);
    for (; u < uend; u += ustride) {
        if (h != hw) {
            const float* W = p.sgu_w + ((size_t)(l * 4 + h) * 128 + pp) * 128 + g * 8;
#pragma unroll
            for (int ks = 0; ks < 4; ++ks) { const f32x4 w0 = *(const f32x4*)(W + ks * 32), w1 = *(const f32x4*)(W + ks * 32 + 4);
                u32x4 w; w.x = pk2(w0[0], w0[1]); w.y = pk2(w0[2], w0[3]); w.z = pk2(w1[0], w1[1]); w.w = pk2(w1[2], w1[3]); wf[ks] = __builtin_bit_cast(bf16x8, w); }
            bs = p.sgu_b[(l * 4 + h) * 128 + pp];
#pragma unroll
            for (int ct = 0; ct < 4; ++ct) gv[ct] = *(const f32x4*)(p.head_g + l * 1024 + h * 64 + 4 * g + ct * 16);
            hw = h;
        }
        const int un = u + ustride; int r0n = r0, hn = h;
        u32x4 van = va, vbn = vb; u32x2 uun[4];
#pragma unroll
        for (int ct = 0; ct < 4; ++ct) uun[ct] = uu[ct];
        if (un < uend) { decode(un, r0n, hn); SGU_LOADROWS(r0n, hn, van, vbn, uun); }
        {
            float v[16] = {bflo(va.x), bfhi(va.x), bflo(va.y), bfhi(va.y), bflo(va.z), bfhi(va.z), bflo(va.w), bfhi(va.w),
                           bflo(vb.x), bfhi(vb.x), bflo(vb.y), bfhi(vb.y), bflo(vb.z), bfhi(vb.z), bflo(vb.w), bfhi(vb.w)};
            float ss = 0.f;
#pragma unroll
            for (int i = 0; i < 16; ++i) { v[i] = gelu_tanh(v[i]); ss += v[i] * v[i]; }
            ss += __shfl_xor(ss, 1); ss += __shfl_xor(ss, 2);
            const float rstd = rsqrtf(ss * (1.f / 64.f) + EPS);
#pragma unroll
            for (int i = 0; i < 16; ++i) *(LAS bf16_t*)(smem + (part * 16 + i) * VS + q * 2) = (bf16_t)f2bf(v[i] * rstd);
        }
        __syncthreads();
        f32x4 acc[4];
#pragma unroll
        for (int ct = 0; ct < 4; ++ct) {
            acc[ct] = (f32x4){0.f, 0.f, 0.f, 0.f};
#pragma unroll
            for (int ks = 0; ks < 4; ++ks) {
                const bf16x8 af = *(const LAS bf16x8*)(smem + (ct * 16 + fr) * VS + (ks * 32 + g * 8) * 2);
                acc[ct] = __builtin_amdgcn_mfma_f32_16x16x32_bf16(af, wf[ks], acc[ct], 0, 0, 0);
            }
        }
        {
            bf16_t* yd = Y + (size_t)(r0 + pp) * 1024 + h * 64 + 4 * g;
            float o[4][4]; float ss = 0.f;
#pragma unroll
            for (int ct = 0; ct < 4; ++ct) {
                o[ct][0] = gelu_tanh(bflo(uu[ct].x)) * (acc[ct][0] + bs); o[ct][1] = gelu_tanh(bfhi(uu[ct].x)) * (acc[ct][1] + bs);
                o[ct][2] = gelu_tanh(bflo(uu[ct].y)) * (acc[ct][2] + bs); o[ct][3] = gelu_tanh(bfhi(uu[ct].y)) * (acc[ct][3] + bs);
                ss += (o[ct][0] * o[ct][0] + o[ct][1] * o[ct][1]) + (o[ct][2] * o[ct][2] + o[ct][3] * o[ct][3]);
            }
            ss += __shfl_xor(ss, 16); ss += __shfl_xor(ss, 32);
            const float rs = rsqrtf(ss * (1.f / 64.f) + EPS);
#pragma unroll
            for (int ct = 0; ct < 4; ++ct) {
                u32x2 w; w.x = pk2(o[ct][0] * rs * gv[ct][0], o[ct][1] * rs * gv[ct][1]); w.y = pk2(o[ct][2] * rs * gv[ct][2], o[ct][3] * rs * gv[ct][3]);
                *(u32x2*)(yd + ct * 16) = w;
            }
        }
        __syncthreads();
        r0 = r0n; h = hn; va = van; vb = vbn;
#pragma unroll
        for (int ct = 0; ct < 4; ++ct) uu[ct] = uun[ct];
    }
#undef SGU_LOADROWS
}

__device__ __forceinline__ void phase_fourier(const Params& p, int l, LAS char* smem) {
    bf16_t* Y = (bf16_t*)(p.ws + WS_S2) + (size_t)NROW * 1024;
    { LAS float* hl = (LAS float*)(smem + LDS_EXTRA); const int t = otid(); if (t < 256) hl[t] = p.head_g[l * 1024 + 256 + t]; __syncthreads(); }
    {
        pg8::Gemm g{(const bf16_t*)(p.ws + WS_DFT2), (const bf16_t*)(p.ws + WS_ZT), 2048, NB * 256, 4096, nullptr};
        pg8::FourierOrder S{8, (int)gridDim.x, (int)blockIdx.x};
        pg8::EpiFourier E{Y, 0, 2048, 0.0027621358640099515f, (const LAS float*)(smem + LDS_EXTRA)};
        pg8::gemm_phase((LAS unsigned char*)smem, g, S, E);
    }
    if (l == 0) {
        pg8::Gemm g{(const bf16_t*)(p.ws + WS_DFTC2), (const bf16_t*)(p.ws + WS_ZT) + (size_t)NB * 256 * 4096, 256, NB * 256, 512, nullptr};
        pg8::FourierOrder S{1, (int)gridDim.x, (int)((blockIdx.x + 128) % gridDim.x)};
        pg8::EpiFourier E{Y, NLAT, 256, 0.0078125f, (const LAS float*)(smem + LDS_EXTRA)};
        pg8::gemm_phase((LAS unsigned char*)smem, g, S, E);
    }
}

template <bool DIFF>
__device__ __forceinline__ void attn_simple_unit(const Params& p, int qrow0, int qcol, int kcol, int vcol,
                                 int k0row, int k0n, int k1row, int k1n, float scale, float Mb, float lam, int ycol, LAS char* smem) {
    const int tid = otid(), qi = tid >> 1, half = tid & 1;
    const bf16_t* PX = (const bf16_t*)(p.ws + WS_S1);
    bf16_t* Y = (bf16_t*)(p.ws + WS_S2) + (size_t)NROW * 1024;
    LAS float* sk = (LAS float*)smem;
    LAS float* sv = sk + 64 * 64;
    const int qr = qrow0 + qi;
    float q[64];
    {
        const bf16_t* src = PX + (size_t)qr * INW + qcol;
#pragma unroll
        for (int i = 0; i < 8; ++i) { const u32x4 a = *(const u32x4*)(src + i * 8);
            q[i * 8 + 0] = bflo(a.x) * scale; q[i * 8 + 1] = bfhi(a.x) * scale; q[i * 8 + 2] = bflo(a.y) * scale; q[i * 8 + 3] = bfhi(a.y) * scale;
            q[i * 8 + 4] = bflo(a.z) * scale; q[i * 8 + 5] = bfhi(a.z) * scale; q[i * 8 + 6] = bflo(a.w) * scale; q[i * 8 + 7] = bfhi(a.w) * scale; }
    }
    float o0[32], o1[32]; float l0 = 0.f, l1 = 0.f;
#pragma unroll
    for (int i = 0; i < 32; ++i) { o0[i] = 0.f; o1[i] = 0.f; }
    const int ntile = (k0n + k1n) >> 6, nt0 = k0n >> 6;
    for (int kt = 0; kt < ntile; ++kt) {
        const int krow = kt < nt0 ? k0row + kt * 64 : k1row + (kt - nt0) * 64;
        __syncthreads();
        {
            const int key = tid >> 3, part = tid & 7;
            const bf16_t* ks = PX + (size_t)(krow + key) * INW + kcol + part * 8;
            const bf16_t* vs = PX + (size_t)(krow + key) * INW + vcol + part * 8;
            const u32x4 a = *(const u32x4*)ks, b = *(const u32x4*)vs;
            LAS float* dk = sk + key * 64 + part * 8; LAS float* dv = sv + key * 64 + part * 8;
            *(LAS f32x4*)dk = (f32x4){bflo(a.x), bfhi(a.x), bflo(a.y), bfhi(a.y)}; *(LAS f32x4*)(dk + 4) = (f32x4){bflo(a.z), bfhi(a.z), bflo(a.w), bfhi(a.w)};
            *(LAS f32x4*)dv = (f32x4){bflo(b.x), bfhi(b.x), bflo(b.y), bfhi(b.y)}; *(LAS f32x4*)(dv + 4) = (f32x4){bflo(b.z), bfhi(b.z), bflo(b.w), bfhi(b.w)};
        }
        __syncthreads();
#pragma unroll 1
        for (int key = 0; key < 64; ++key) {
            float s0 = 0.f, s1 = 0.f;
#pragma unroll
            for (int d4 = 0; d4 < 8; ++d4) { const f32x4 kk = *(LAS f32x4*)(sk + key * 64 + d4 * 4);
                s0 += q[d4 * 4] * kk[0] + q[d4 * 4 + 1] * kk[1] + q[d4 * 4 + 2] * kk[2] + q[d4 * 4 + 3] * kk[3];
                if ((d4 & 3) == 3) __builtin_amdgcn_sched_barrier(0); }
#pragma unroll
            for (int d4 = 8; d4 < 16; ++d4) { const f32x4 kk = *(LAS f32x4*)(sk + key * 64 + d4 * 4);
                s1 += q[d4 * 4] * kk[0] + q[d4 * 4 + 1] * kk[1] + q[d4 * 4 + 2] * kk[2] + q[d4 * 4 + 3] * kk[3];
                if ((d4 & 3) == 3) __builtin_amdgcn_sched_barrier(0); }
            if (DIFF) {
                const float p0 = __expf(s0 - Mb), p1 = __expf(s1 - Mb);
                l0 += p0; l1 += p1;
#pragma unroll
                for (int d4 = 0; d4 < 8; ++d4) { const f32x4 vv = *(LAS f32x4*)(sv + key * 64 + half * 32 + d4 * 4);
#pragma unroll
                    for (int j = 0; j < 4; ++j) { o0[d4 * 4 + j] += p0 * vv[j]; o1[d4 * 4 + j] += p1 * vv[j]; }
                    if ((d4 & 3) == 3) __builtin_amdgcn_sched_barrier(0); }
            } else {
                const float p0 = __expf(s0 + s1 - Mb);
                l0 += p0;
#pragma unroll
                for (int d4 = 0; d4 < 8; ++d4) { const f32x4 vv = *(LAS f32x4*)(sv + key * 64 + half * 32 + d4 * 4);
#pragma unroll
                    for (int j = 0; j < 4; ++j) o0[d4 * 4 + j] += p0 * vv[j];
                    if ((d4 & 3) == 3) __builtin_amdgcn_sched_barrier(0); }
            }
        }
    }
    {
        const float i0 = 1.f / l0, i1 = DIFF ? lam / l1 : 0.f;
        bf16_t* yd = Y + (size_t)qr * 1024 + ycol + half * 32;
#pragma unroll
        for (int i = 0; i < 4; ++i) {
            float o[8];
#pragma unroll
            for (int j = 0; j < 8; ++j) o[j] = DIFF ? (o0[i * 8 + j] * i0 - o1[i * 8 + j] * i1) : o0[i * 8 + j] * i0;
            u32x4 w; w.x = pk2(o[0], o[1]); w.y = pk2(o[2], o[3]); w.z = pk2(o[4], o[5]); w.w = pk2(o[6], o[7]);
            *(u32x4*)(yd + i * 8) = w;
        }
    }
    __syncthreads();
}

__device__ __forceinline__ void na_unit(const Params& p, int l, int unit, LAS char* smem) {
    const int tid = otid(), col = tid & 63, split = tid >> 6;
    const bf16_t* PX = (const bf16_t*)(p.ws + WS_S1);
    bf16_t* Y = (bf16_t*)(p.ws + WS_S2) + (size_t)NROW * 1024;
    const float* CST = (const float*)(p.ws + WS_CONST);
    const float Mb = CST[l * 8 + 2];
    const int b = unit >> 7, h = (unit >> 5) & 3, r = unit & 31;
    const int rstart = min(max(r - 4, 0), 24), wstart = min(max(col - 8, 0), 48);
    const int qr = b * 2048 + r * 64 + col;
    LAS float* sq = (LAS float*)smem;
    __syncthreads();
    {
        const int qc = tid >> 3, part = tid & 7;
        const u32x4 a = *(const u32x4*)(PX + (size_t)(b * 2048 + r * 64 + qc) * INW + C_DQ + h * 64 + part * 8);
        LAS float* d = sq + qc * 65 + part * 8;
        d[0] = bflo(a.x) * 0.125f; d[1] = bfhi(a.x) * 0.125f; d[2] = bflo(a.y) * 0.125f; d[3] = bfhi(a.y) * 0.125f;
        d[4] = bflo(a.z) * 0.125f; d[5] = bfhi(a.z) * 0.125f; d[6] = bflo(a.w) * 0.125f; d[7] = bfhi(a.w) * 0.125f;
    }
    __syncthreads();
    float o[64]; float lsum = 0.f;
#pragma unroll
    for (int i = 0; i < 64; ++i) o[i] = 0.f;
    const int kr = rstart + split;
    const float* bias = p.rpb + ((size_t)(l * 4 + h) * 15 + (kr - r + 7)) * 31;
#pragma unroll 1
    for (int kk = 0; kk < 48; ++kk) {
        int krow; float bs = 0.f;
        if (kk < 16) { const int kc = wstart + kk; krow = b * 2048 + kr * 64 + kc; bs = bias[kc - col + 15]; }
        else krow = NLAT + b * 256 + split * 32 + (kk - 16);
        const bf16_t* ks = PX + (size_t)krow * INW + C_DK + h * 64;
        const bf16_t* vs = PX + (size_t)krow * INW + C_DV + h * 64;
        float s = bs;
#pragma unroll
        for (int i = 0; i < 8; ++i) { const u32x4 a = *(const u32x4*)(ks + i * 8); const LAS float* qq = sq + col * 65 + i * 8;
            s += qq[0] * bflo(a.x) + qq[1] * bfhi(a.x) + qq[2] * bflo(a.y) + qq[3] * bfhi(a.y)
               + qq[4] * bflo(a.z) + qq[5] * bfhi(a.z) + qq[6] * bflo(a.w) + qq[7] * bfhi(a.w); }
        const float pr = __expf(s - Mb);
        lsum += pr;
#pragma unroll
        for (int i = 0; i < 8; ++i) { const u32x4 a = *(const u32x4*)(vs + i * 8);
            o[i * 8 + 0] += pr * bflo(a.x); o[i * 8 + 1] += pr * bfhi(a.x); o[i * 8 + 2] += pr * bflo(a.y); o[i * 8 + 3] += pr * bfhi(a.y);
            o[i * 8 + 4] += pr * bflo(a.z); o[i * 8 + 5] += pr * bfhi(a.z); o[i * 8 + 6] += pr * bflo(a.w); o[i * 8 + 7] += pr * bfhi(a.w); }
    }
    LAS float* red = (LAS float*)smem;
    __syncthreads();
#pragma unroll
    for (int i = 0; i < 64; ++i) red[(split * 64 + col) * 65 + i] = o[i];
    red[(split * 64 + col) * 65 + 64] = lsum;
    __syncthreads();
    {
        const int dg = split;
        float ls = 0.f, acc[8];
#pragma unroll
        for (int j = 0; j < 8; ++j) acc[j] = 0.f;
#pragma unroll
        for (int s = 0; s < 8; ++s) { ls += red[(s * 64 + col) * 65 + 64];
#pragma unroll
            for (int j = 0; j < 8; ++j) acc[j] += red[(s * 64 + col) * 65 + dg * 8 + j]; }
        const float inv = 1.f / ls;
        u32x4 w; w.x = pk2(acc[0] * inv, acc[1] * inv); w.y = pk2(acc[2] * inv, acc[3] * inv); w.z = pk2(acc[4] * inv, acc[5] * inv); w.w = pk2(acc[6] * inv, acc[7] * inv);
        *(u32x4*)(Y + (size_t)qr * 1024 + 768 + h * 64 + dg * 8) = w;
    }
    __syncthreads();
}


__device__ __forceinline__ void diffattn_unit(const Params& p, int qrow0, int h, int krowA, int ntA, const bf16_t* vtA, int vtsA,
                                              int krowB, const bf16_t* vtB, int vtsB, int nt, float c2, float lam, const float* hg, float hs, LAS char* smem) {
    const int tid = otid(), lane = tid & 63, wave = tid >> 6, fr = lane & 15, g = lane >> 4;
    const bf16_t* PX = (const bf16_t*)(p.ws + WS_S1);
    bf16_t* Y = (bf16_t*)(p.ws + WS_S2) + (size_t)NROW * 1024;
    constexpr int KS = 160, VS = 136, TS = 64 * KS, BS = TS + 64 * VS;
    bf16x8 qf[2][2];
#pragma unroll
    for (int qt = 0; qt < 2; ++qt) { const bf16_t* qsrc = PX + (size_t)(qrow0 + wave * 32 + qt * 16 + fr) * INW + C_CQ + h * 64 + g * 8;
        qf[qt][0] = *(const bf16x8*)qsrc; qf[qt][1] = *(const bf16x8*)(qsrc + 32); }
    const int srow = tid >> 3, schunk = tid & 7;
    const int sdst = srow * KS + schunk * 16, vdst = srow * VS + schunk * 16;
    f32x4 O[2][2][4];
#pragma unroll
    for (int qt = 0; qt < 2; ++qt)
#pragma unroll
        for (int m = 0; m < 2; ++m)
#pragma unroll
            for (int dt = 0; dt < 4; ++dt) O[qt][m][dt] = (f32x4){0.f, 0.f, 0.f, 0.f};
    f32x4 L[2][2];
#pragma unroll
    for (int qt = 0; qt < 2; ++qt)
#pragma unroll
        for (int m = 0; m < 2; ++m) L[qt][m] = (f32x4){0.f, 0.f, 0.f, 0.f};
    const bf16x8 ones = {(short)0x3F80, (short)0x3F80, (short)0x3F80, (short)0x3F80, (short)0x3F80, (short)0x3F80, (short)0x3F80, (short)0x3F80};
    const f32x4 sinit = (f32x4){-c2, -c2, -c2, -c2};
    u32x4 rk, rv;
#define DA_GLOAD(t) do { const int _t = (t); \
        if (_t < ntA) { rk = *(const u32x4*)(PX + (size_t)(krowA + _t * 64 + srow) * INW + C_CK + h * 64 + schunk * 8); rv = *(const u32x4*)(vtA + (size_t)(h * 64 + srow) * vtsA + _t * 64 + schunk * 8); } \
        else { const int _u = _t - ntA; rk = *(const u32x4*)(PX + (size_t)(krowB + _u * 64 + srow) * INW + C_CK + h * 64 + schunk * 8); rv = *(const u32x4*)(vtB + (size_t)(h * 64 + srow) * vtsB + _u * 64 + schunk * 8); } } while (0)
    DA_GLOAD(0);
    *(LAS u32x4*)(smem + sdst) = rk; *(LAS u32x2*)(smem + TS + vdst) = (u32x2){rv.x, rv.y}; *(LAS u32x2*)(smem + TS + vdst + 8) = (u32x2){rv.z, rv.w};
    __syncthreads();
    for (int t = 0; t < nt; ++t) {
        if (t + 1 < nt) DA_GLOAD(t + 1);
        LAS char* kb = smem + (t & 1) * BS; LAS char* vb = kb + TS;
#pragma unroll
        for (int half = 0; half < 2; ++half) {
            bf16x8 kf[2][2], vf[4];
#pragma unroll
            for (int m = 0; m < 2; ++m)
#pragma unroll
                for (int kt = 0; kt < 2; ++kt) kf[m][kt] = *(const LAS bf16x8*)(kb + (half * 32 + kt * 16 + fr) * KS + m * 64 + g * 16);
#pragma unroll
            for (int dt = 0; dt < 4; ++dt) {
                const LAS char* vp = vb + (dt * 16 + fr) * VS + (half * 32 + 4 * g) * 2;
                const u32x2 lo = *(const LAS u32x2*)vp, hi = *(const LAS u32x2*)(vp + 32);
                u32x4 w; w.x = lo.x; w.y = lo.y; w.z = hi.x; w.w = hi.y;
                vf[dt] = __builtin_bit_cast(bf16x8, w);
            }
            __builtin_amdgcn_sched_barrier(0);
            f32x4 s[2][2][2];
#pragma unroll
            for (int m = 0; m < 2; ++m)
#pragma unroll
                for (int kt = 0; kt < 2; ++kt) {
                    s[0][m][kt] = __builtin_amdgcn_mfma_f32_16x16x32_bf16(kf[m][kt], qf[0][m], sinit, 0, 0, 0);
                    s[1][m][kt] = __builtin_amdgcn_mfma_f32_16x16x32_bf16(kf[m][kt], qf[1][m], sinit, 0, 0, 0);
                }
            bf16x8 pa[2][2];
#pragma unroll
            for (int qt = 0; qt < 2; ++qt)
#pragma unroll
                for (int m = 0; m < 2; ++m) {
                    float pv[8];
#pragma unroll
                    for (int kt = 0; kt < 2; ++kt)
#pragma unroll
                        for (int r = 0; r < 4; ++r) pv[kt * 4 + r] = __builtin_amdgcn_exp2f(s[qt][m][kt][r]);
                    u32x4 w; w.x = pg8::cvt_pk_bf16(pv[0], pv[1]); w.y = pg8::cvt_pk_bf16(pv[2], pv[3]); w.z = pg8::cvt_pk_bf16(pv[4], pv[5]); w.w = pg8::cvt_pk_bf16(pv[6], pv[7]);
                    pa[qt][m] = __builtin_bit_cast(bf16x8, w);
                    L[qt][m] = __builtin_amdgcn_mfma_f32_16x16x32_bf16(pa[qt][m], ones, L[qt][m], 0, 0, 0);
                }
#pragma unroll
            for (int dt = 0; dt < 4; ++dt)
#pragma unroll
                for (int qt = 0; qt < 2; ++qt) {
                    O[qt][0][dt] = __builtin_amdgcn_mfma_f32_16x16x32_bf16(pa[qt][0], vf[dt], O[qt][0][dt], 0, 0, 0);
                    O[qt][1][dt] = __builtin_amdgcn_mfma_f32_16x16x32_bf16(pa[qt][1], vf[dt], O[qt][1][dt], 0, 0, 0);
                }
        }
        if (t + 1 < nt) { LAS char* nb = smem + ((t + 1) & 1) * BS; *(LAS u32x4*)(nb + sdst) = rk; *(LAS u32x2*)(nb + TS + vdst) = (u32x2){rv.x, rv.y}; *(LAS u32x2*)(nb + TS + vdst + 8) = (u32x2){rv.z, rv.w}; }
        __syncthreads();
    }
#undef DA_GLOAD
    float hgv[4];
#pragma unroll
    for (int dt = 0; dt < 4; ++dt) hgv[dt] = hg[h * 64 + dt * 16 + fr] * hs;
#pragma unroll
    for (int qt = 0; qt < 2; ++qt) {
#pragma unroll
        for (int r = 0; r < 4; ++r) {
            const float i0 = 1.f / L[qt][0][r], i1 = lam / L[qt][1][r];
            float v[4], ss = 0.f;
#pragma unroll
            for (int dt = 0; dt < 4; ++dt) { v[dt] = O[qt][0][dt][r] * i0 - O[qt][1][dt][r] * i1; ss += v[dt] * v[dt]; }
            ss += __shfl_xor(ss, 1); ss += __shfl_xor(ss, 2); ss += __shfl_xor(ss, 4); ss += __shfl_xor(ss, 8);
            const float rs = rsqrtf(ss * (1.f / 64.f) + EPS);
            bf16_t* yd = Y + (size_t)(qrow0 + wave * 32 + qt * 16 + 4 * g + r) * 1024 + 512 + h * 64 + fr;
#pragma unroll
            for (int dt = 0; dt < 4; ++dt) yd[dt * 16] = (bf16_t)f2bf(v[dt] * rs * hgv[dt]);
        }
    }
}

__device__ __forceinline__ void na_mfma_unit(const Params& p, int l, int b, int h, int rp, bool ctxq, int qb, float c1, float c2, LAS char* smem) {
    const int tid = otid(), lane = tid & 63, wave = tid >> 6, fr = lane & 15, g = lane >> 4;
    const bf16_t* PX = (const bf16_t*)(p.ws + WS_S1);
    const bf16_t* VTD = (const bf16_t*)(p.ws + WS_VTD);
    bf16_t* Y = (bf16_t*)(p.ws + WS_S2) + (size_t)NROW * 1024;
    constexpr int KS = 160, VS = 136, TS = 64 * KS, BS = TS + 64 * VS;
    LAS float* tab = (LAS float*)(smem + 2 * BS);
    const int r = ctxq ? 0 : 2 * rp + (wave >> 2), j = wave & 3;
    const int qrow = ctxq ? NLAT + b * 256 + qb * 128 + wave * 16 : b * 2048 + r * 64 + 16 * j;
    const int rs = min(max(r - 4, 0), 24);
    const int kr_lo = min(max(2 * rp - 4, 0), 24), nloc = ctxq ? 0 : (min(max(2 * rp - 3, 0), 24) + 7 - kr_lo + 1), nt = nloc + 4;
    const int kstart = min(max(16 * j - 8, 0), 32), qc = 16 * j + fr, wstart = min(max(qc - 8, 0), 48);
    if (!ctxq) for (int i = tid; i < 465; i += NT) tab[i] = p.rpb[(size_t)(l * 4 + h) * 465 + i] * 1.4426950408889634f;
    const f32x4 sinit = (f32x4){-c2, -c2, -c2, -c2};
    const bf16x8 ones = {(short)0x3F80, (short)0x3F80, (short)0x3F80, (short)0x3F80, (short)0x3F80, (short)0x3F80, (short)0x3F80, (short)0x3F80};
    f32x4 Ls = (f32x4){0.f, 0.f, 0.f, 0.f};
    const bf16_t* qsrc = PX + (size_t)(qrow + fr) * INW + C_DQ + h * 64 + g * 8;
    const bf16x8 qf0 = *(const bf16x8*)qsrc, qf1 = *(const bf16x8*)(qsrc + 32);
    const int srow = tid >> 3, schunk = tid & 7, sdst = srow * KS + schunk * 16, vdst = srow * VS + schunk * 16;
    f32x4 O[4];
#pragma unroll
    for (int dt = 0; dt < 4; ++dt) O[dt] = (f32x4){0.f, 0.f, 0.f, 0.f};
    u32x4 rk, rv;
    const bf16_t* vt_lat = VTD + (size_t)b * 256 * 2048 + (size_t)(h * 64 + srow) * 2048 + schunk * 8;
    const bf16_t* vt_ctx = VTD + VT_CTX_OFF + (size_t)b * 256 * 256 + (size_t)(h * 64 + srow) * 256 + schunk * 8;
#define NA_GLOAD(t) do { const int _t = (t); \
        if (_t < nloc) { const int _kr = kr_lo + _t; rk = *(const u32x4*)(PX + (size_t)(b * 2048 + _kr * 64 + srow) * INW + C_DK + h * 64 + schunk * 8); rv = *(const u32x4*)(vt_lat + _kr * 64); } \
        else { const int _u = _t - nloc; rk = *(const u32x4*)(PX + (size_t)(NLAT + b * 256 + _u * 64 + srow) * INW + C_DK + h * 64 + schunk * 8); rv = *(const u32x4*)(vt_ctx + _u * 64); } } while (0)
    NA_GLOAD(0);
    *(LAS u32x4*)(smem + sdst) = rk; *(LAS u32x2*)(smem + TS + vdst) = (u32x2){rv.x, rv.y}; *(LAS u32x2*)(smem + TS + vdst + 8) = (u32x2){rv.z, rv.w};
    __syncthreads();
    for (int t = 0; t < nt; ++t) {
        if (t + 1 < nt) NA_GLOAD(t + 1);
        LAS char* kb = smem + (t & 1) * BS; LAS char* vb = kb + TS;
        const bool local = t < nloc; const int kr = kr_lo + t;
        const int nhalf = local ? ((kr >= rs && kr <= rs + 7) ? 1 : 0) : 2;
        for (int half = 0; half < nhalf; ++half) {
            const int koff = local ? kstart : half * 32;
            f32x4 s[2];
#pragma unroll
            for (int kt = 0; kt < 2; ++kt) {
                const LAS char* kp = kb + (koff + kt * 16 + fr) * KS + g * 16;
                const bf16x8 k0 = *(const LAS bf16x8*)kp, k1 = *(const LAS bf16x8*)(kp + 64);
                s[kt] = __builtin_amdgcn_mfma_f32_16x16x32_bf16(k0, qf0, sinit, 0, 0, 0);
                s[kt] = __builtin_amdgcn_mfma_f32_16x16x32_bf16(k1, qf1, s[kt], 0, 0, 0);
            }
            float pv[8];
            if (local) {
                const LAS float* trow = tab + (kr - r + 7) * 31;
#pragma unroll
                for (int kt = 0; kt < 2; ++kt)
#pragma unroll
                    for (int rr = 0; rr < 4; ++rr) {
                        const int kc = koff + 16 * kt + 4 * g + rr;
                        const bool valid = (kc >= wstart) && (kc < wstart + 16);
                        const float bs = trow[valid ? kc - qc + 15 : 0];
                        const float e = __builtin_amdgcn_exp2f(s[kt][rr] + bs);
                        pv[kt * 4 + rr] = valid ? e : 0.f;
                    }
            } else {
#pragma unroll
                for (int kt = 0; kt < 2; ++kt)
#pragma unroll
                    for (int rr = 0; rr < 4; ++rr) pv[kt * 4 + rr] = __builtin_amdgcn_exp2f(s[kt][rr]);
            }
            u32x4 w; w.x = pg8::cvt_pk_bf16(pv[0], pv[1]); w.y = pg8::cvt_pk_bf16(pv[2], pv[3]); w.z = pg8::cvt_pk_bf16(pv[4], pv[5]); w.w = pg8::cvt_pk_bf16(pv[6], pv[7]);
            const bf16x8 pa = __builtin_bit_cast(bf16x8, w);
            Ls = __builtin_amdgcn_mfma_f32_16x16x32_bf16(pa, ones, Ls, 0, 0, 0);
#pragma unroll
            for (int dt = 0; dt < 4; ++dt) {
                const LAS char* vp = vb + (dt * 16 + fr) * VS + (koff + 4 * g) * 2;
                const u32x2 lo = *(const LAS u32x2*)vp, hi = *(const LAS u32x2*)(vp + 32);
                u32x4 v; v.x = lo.x; v.y = lo.y; v.z = hi.x; v.w = hi.y;
                O[dt] = __builtin_amdgcn_mfma_f32_16x16x32_bf16(pa, __builtin_bit_cast(bf16x8, v), O[dt], 0, 0, 0);
            }
        }
        if (t + 1 < nt) { LAS char* nb = smem + ((t + 1) & 1) * BS; *(LAS u32x4*)(nb + sdst) = rk; *(LAS u32x2*)(nb + TS + vdst) = (u32x2){rv.x, rv.y}; *(LAS u32x2*)(nb + TS + vdst + 8) = (u32x2){rv.z, rv.w}; }
        __syncthreads();
    }
#undef NA_GLOAD
    float hgv[4];
#pragma unroll
    for (int dt = 0; dt < 4; ++dt) hgv[dt] = p.head_g[l * 1024 + 768 + h * 64 + dt * 16 + fr];
#pragma unroll
    for (int rr = 0; rr < 4; ++rr) {
        const float inv = 1.f / Ls[rr];
        float v[4], ss = 0.f;
#pragma unroll
        for (int dt = 0; dt < 4; ++dt) { v[dt] = O[dt][rr] * inv; ss += v[dt] * v[dt]; }
        ss += __shfl_xor(ss, 1); ss += __shfl_xor(ss, 2); ss += __shfl_xor(ss, 4); ss += __shfl_xor(ss, 8);
        const float rs = rsqrtf(ss * (1.f / 64.f) + EPS);
        bf16_t* yd = Y + (size_t)(qrow + 4 * g + rr) * 1024 + 768 + h * 64 + fr;
#pragma unroll
        for (int dt = 0; dt < 4; ++dt) yd[dt * 16] = (bf16_t)f2bf(v[dt] * rs * hgv[dt]);
    }
}


__device__ __forceinline__ void na_mfma_unit2(const Params& p, int l, int b, int h, int rq, float c2, LAS char* smem) {
    const int tid = otid(), lane = tid & 63, wave = tid >> 6, fr = lane & 15, g = lane >> 4;
    const bf16_t* PX = (const bf16_t*)(p.ws + WS_S1);
    const bf16_t* VTD = (const bf16_t*)(p.ws + WS_VTD);
    bf16_t* Y = (bf16_t*)(p.ws + WS_S2) + (size_t)NROW * 1024;
    constexpr int KS = 160, VS = 136, TS = 64 * KS, BS = TS + 64 * VS;
    LAS float* tab = (LAS float*)(smem + 2 * BS);
    const int j = wave & 3, r0 = 4 * rq + 2 * (wave >> 2), r1 = r0 + 1;
    const int rs0 = min(max(r0 - 4, 0), 24), rs1 = min(max(r1 - 4, 0), 24);
    const int kr_lo = min(max(4 * rq - 4, 0), 24), nloc = min(max(4 * rq - 1, 0), 24) + 7 - kr_lo + 1, nt = nloc + 4;
    const int kstart = min(max(16 * j - 8, 0), 32), qc = 16 * j + fr, wstart = min(max(qc - 8, 0), 48);
    for (int i = tid; i < 465; i += NT) tab[i] = p.rpb[(size_t)(l * 4 + h) * 465 + i] * 1.4426950408889634f;
    const f32x4 sinit = (f32x4){-c2, -c2, -c2, -c2};
    const bf16x8 ones = {(short)0x3F80, (short)0x3F80, (short)0x3F80, (short)0x3F80, (short)0x3F80, (short)0x3F80, (short)0x3F80, (short)0x3F80};
    bf16x8 qf[2][2];
#pragma unroll
    for (int qt = 0; qt < 2; ++qt) { const bf16_t* qsrc = PX + (size_t)(b * 2048 + (r0 + qt) * 64 + 16 * j + fr) * INW + C_DQ + h * 64 + g * 8;
        qf[qt][0] = *(const bf16x8*)qsrc; qf[qt][1] = *(const bf16x8*)(qsrc + 32); }
    const int srow = tid >> 3, schunk = tid & 7, sdst = srow * KS + schunk * 16, vdst = srow * VS + schunk * 16;
    f32x4 O[2][4], Ls[2];
#pragma unroll
    for (int qt = 0; qt < 2; ++qt) { Ls[qt] = (f32x4){0.f, 0.f, 0.f, 0.f};
#pragma unroll
        for (int dt = 0; dt < 4; ++dt) O[qt][dt] = (f32x4){0.f, 0.f, 0.f, 0.f}; }
    u32x4 rk, rv;
    const bf16_t* vt_lat = VTD + (size_t)b * 256 * 2048 + (size_t)(h * 64 + srow) * 2048 + schunk * 8;
    const bf16_t* vt_ctx = VTD + VT_CTX_OFF + (size_t)b * 256 * 256 + (size_t)(h * 64 + srow) * 256 + schunk * 8;
#define NA_GLOAD(t) do { const int _t = (t); \
        if (_t < nloc) { const int _kr = kr_lo + _t; rk = *(const u32x4*)(PX + (size_t)(b * 2048 + _kr * 64 + srow) * INW + C_DK + h * 64 + schunk * 8); rv = *(const u32x4*)(vt_lat + _kr * 64); } \
        else { const int _u = _t - nloc; rk = *(const u32x4*)(PX + (size_t)(NLAT + b * 256 + _u * 64 + srow) * INW + C_DK + h * 64 + schunk * 8); rv = *(const u32x4*)(vt_ctx + _u * 64); } } while (0)
    NA_GLOAD(0);
    *(LAS u32x4*)(smem + sdst) = rk; *(LAS u32x2*)(smem + TS + vdst) = (u32x2){rv.x, rv.y}; *(LAS u32x2*)(smem + TS + vdst + 8) = (u32x2){rv.z, rv.w};
    __syncthreads();
    for (int t = 0; t < nt; ++t) {
        if (t + 1 < nt) NA_GLOAD(t + 1);
        LAS char* kb = smem + (t & 1) * BS; LAS char* vb = kb + TS;
        const bool local = t < nloc; const int kr = kr_lo + t;
        const bool in0 = kr >= rs0 && kr <= rs0 + 7, in1 = kr >= rs1 && kr <= rs1 + 7;
        const int nhalf = local ? ((in0 || in1) ? 1 : 0) : 2;
        for (int half = 0; half < nhalf; ++half) {
            const int koff = local ? kstart : half * 32;
            f32x4 s[2][2];
#pragma unroll
            for (int kt = 0; kt < 2; ++kt) {
                const LAS char* kp = kb + (koff + kt * 16 + fr) * KS + g * 16;
                const bf16x8 k0 = *(const LAS bf16x8*)kp, k1 = *(const LAS bf16x8*)(kp + 64);
#pragma unroll
                for (int qt = 0; qt < 2; ++qt) {
                    s[qt][kt] = __builtin_amdgcn_mfma_f32_16x16x32_bf16(k0, qf[qt][0], sinit, 0, 0, 0);
                    s[qt][kt] = __builtin_amdgcn_mfma_f32_16x16x32_bf16(k1, qf[qt][1], s[qt][kt], 0, 0, 0);
                }
            }
            bf16x8 pa[2];
#pragma unroll
            for (int qt = 0; qt < 2; ++qt) {
                float pv[8];
                if (local) {
                    const bool inq = qt ? in1 : in0;
                    const LAS float* trow = tab + (inq ? (kr - (r0 + qt) + 7) * 31 : 0);
#pragma unroll
                    for (int kt = 0; kt < 2; ++kt)
#pragma unroll
                        for (int rr = 0; rr < 4; ++rr) {
                            const int kc = koff + 16 * kt + 4 * g + rr;
                            const bool valid = inq && (kc >= wstart) && (kc < wstart + 16);
                            const float bs = trow[valid ? kc - qc + 15 : 0];
                            const float e = __builtin_amdgcn_exp2f(s[qt][kt][rr] + bs);
                            pv[kt * 4 + rr] = valid ? e : 0.f;
                        }
                } else {
#pragma unroll
                    for (int kt = 0; kt < 2; ++kt)
#pragma unroll
                        for (int rr = 0; rr < 4; ++rr) pv[kt * 4 + rr] = __builtin_amdgcn_exp2f(s[qt][kt][rr]);
                }
                u32x4 w; w.x = pg8::cvt_pk_bf16(pv[0], pv[1]); w.y = pg8::cvt_pk_bf16(pv[2], pv[3]); w.z = pg8::cvt_pk_bf16(pv[4], pv[5]); w.w = pg8::cvt_pk_bf16(pv[6], pv[7]);
                pa[qt] = __builtin_bit_cast(bf16x8, w);
                Ls[qt] = __builtin_amdgcn_mfma_f32_16x16x32_bf16(pa[qt], ones, Ls[qt], 0, 0, 0);
            }
#pragma unroll
            for (int dt = 0; dt < 4; ++dt) {
                const LAS char* vp = vb + (dt * 16 + fr) * VS + (koff + 4 * g) * 2;
                const u32x2 lo = *(const LAS u32x2*)vp, hi = *(const LAS u32x2*)(vp + 32);
                u32x4 v; v.x = lo.x; v.y = lo.y; v.z = hi.x; v.w = hi.y;
                const bf16x8 vf = __builtin_bit_cast(bf16x8, v);
                O[0][dt] = __builtin_amdgcn_mfma_f32_16x16x32_bf16(pa[0], vf, O[0][dt], 0, 0, 0);
                O[1][dt] = __builtin_amdgcn_mfma_f32_16x16x32_bf16(pa[1], vf, O[1][dt], 0, 0, 0);
            }
        }
        if (t + 1 < nt) { LAS char* nb = smem + ((t + 1) & 1) * BS; *(LAS u32x4*)(nb + sdst) = rk; *(LAS u32x2*)(nb + TS + vdst) = (u32x2){rv.x, rv.y}; *(LAS u32x2*)(nb + TS + vdst + 8) = (u32x2){rv.z, rv.w}; }
        __syncthreads();
    }
#undef NA_GLOAD
    float hgv[4];
#pragma unroll
    for (int dt = 0; dt < 4; ++dt) hgv[dt] = p.head_g[l * 1024 + 768 + h * 64 + dt * 16 + fr];
#pragma unroll
    for (int qt = 0; qt < 2; ++qt)
#pragma unroll
        for (int rr = 0; rr < 4; ++rr) {
            const float inv = 1.f / Ls[qt][rr];
            float v[4], ss = 0.f;
#pragma unroll
            for (int dt = 0; dt < 4; ++dt) { v[dt] = O[qt][dt][rr] * inv; ss += v[dt] * v[dt]; }
            ss += __shfl_xor(ss, 1); ss += __shfl_xor(ss, 2); ss += __shfl_xor(ss, 4); ss += __shfl_xor(ss, 8);
            const float rs = rsqrtf(ss * (1.f / 64.f) + EPS);
            bf16_t* yd = Y + (size_t)(b * 2048 + (r0 + qt) * 64 + 16 * j + 4 * g + rr) * 1024 + 768 + h * 64 + fr;
#pragma unroll
            for (int dt = 0; dt < 4; ++dt) yd[dt * 16] = (bf16_t)f2bf(v[dt] * rs * hgv[dt]);
        }
}

__device__ __forceinline__ void phase_mix(const Params& p, int l, LAS char* smem) {
    const float* CST = (const float*)(p.ws + WS_CONST);
    const float lam = CST[l * 8 + 0], MbD = CST[l * 8 + 1], MbN = CST[l * 8 + 2];
    const float sc32 = 0.17677669529663687f;
    const bf16_t* VT = (const bf16_t*)(p.ws + WS_VT);
    const float c2 = MbD * 1.4426950408889634f;
    for (int rep = 0; rep < 1 + (REP_MIX & 1); ++rep)
    for (int u = blockIdx.x; u < 512; u += gridDim.x) {
        const int b = u >> 5, h = (u >> 3) & 3, qb = u & 7;
        diffattn_unit(p, b * 2048 + qb * 256, h, b * 2048, 32, VT + (size_t)b * 256 * 2048, 2048, NLAT + b * 256, VT + VT_CTX_OFF + (size_t)b * 256 * 256, 256, 36, c2, lam, p.head_g + l * 1024 + 512, CST[l * 8 + 3], smem);
    }
    for (int rep = 0; rep < 1 + ((REP_MIX >> 1) & 1); ++rep) phase_fourier(p, l, smem);
    const float c1n = 0.125f * 1.4426950408889634f, c2n = MbN * 1.4426950408889634f;
    for (int rep = 0; rep < 1 + ((REP_MIX >> 2) & 1); ++rep)
    if (gridDim.x == 256) {
        const int c = blockIdx.x, u0 = c < 128 ? c : 128 + (c - 128) * 3, nu = c < 128 ? 1 : 3;
        for (int u = u0; u < u0 + nu; ++u) na_mfma_unit2(p, l, u >> 5, (u >> 3) & 3, u & 7, c2n, smem);
    } else
    for (int u = blockIdx.x; u < 512; u += gridDim.x) na_mfma_unit2(p, l, u >> 5, (u >> 3) & 3, u & 7, c2n, smem);
    for (int rep = 0; rep < 1 + ((REP_MIX >> 3) & 1); ++rep) phase_sgu(p, l, (l == 0) ? 1152 : 1024, smem);
    for (int rep = 0; rep < 1 + ((REP_MIX >> 4) & 1); ++rep)
    if (l == 0) {
        for (int u = (gridDim.x == 256 ? (int)blockIdx.x - 128 : (int)blockIdx.x); u >= 0 && u < 128; u += gridDim.x) {
            const int which = u >> 6, b = (u >> 2) & 15, h = u & 3, r0 = NLAT + b * 256;
            if (which == 0) {
                diffattn_unit(p, r0, h, r0, 4, VT + VT_CTX_OFF + (size_t)b * 256 * 256, 256, r0, VT, 0, 4, c2, lam, p.head_g + l * 1024 + 512, CST[l * 8 + 3], smem);
            } else {
#pragma unroll 1
                for (int qb = 0; qb < 2; ++qb) na_mfma_unit(p, l, b, h, 0, true, qb, c1n, c2n, smem);
            }
        }
    }
}

__device__ __forceinline__ void phase_merge(const Params& p, int l) {
    const int tid = otid(), lane = tid & 63, wave = tid >> 6;
    bf16_t* Y = (bf16_t*)(p.ws + WS_S2) + (size_t)NROW * 1024;
    const float* CST = (const float*)(p.ws + WS_CONST);
    const int nrow = (l == 0) ? NROW : NLAT;
    const int head = lane >> 2;
    const float hs = (head >= 8 && head < 12) ? CST[l * 8 + 3] : 1.f;
    const float* g = p.head_g + l * 1024 + lane * 16;
    const int stride = gridDim.x * 8;
    int r = blockIdx.x * 8 + wave;
    u32x4 na, nb;
    if (r < nrow) { const bf16_t* pn = Y + (size_t)r * 1024 + lane * 16; na = *(const u32x4*)pn; nb = *(const u32x4*)(pn + 8); }
    for (; r < nrow; r += stride) {
        bf16_t* pp = Y + (size_t)r * 1024 + lane * 16;
        const u32x4 a = na, b = nb;
        if (r + stride < nrow) { const bf16_t* pn = Y + (size_t)(r + stride) * 1024 + lane * 16; na = *(const u32x4*)pn; nb = *(const u32x4*)(pn + 8); }
        float v[16] = {bflo(a.x), bfhi(a.x), bflo(a.y), bfhi(a.y), bflo(a.z), bfhi(a.z), bflo(a.w), bfhi(a.w),
                       bflo(b.x), bfhi(b.x), bflo(b.y), bfhi(b.y), bflo(b.z), bfhi(b.z), bflo(b.w), bfhi(b.w)};
        float ss = 0.f;
#pragma unroll
        for (int i = 0; i < 16; ++i) ss += v[i] * v[i];
        ss += __shfl_xor(ss, 1); ss += __shfl_xor(ss, 2);
        const float rstd = rsqrtf(ss * (1.f / 64.f) + EPS) * hs;
#pragma unroll
        for (int i = 0; i < 16; ++i) v[i] = v[i] * rstd * g[i];
        u32x4 w0, w1;
        w0.x = pk2(v[0], v[1]); w0.y = pk2(v[2], v[3]); w0.z = pk2(v[4], v[5]); w0.w = pk2(v[6], v[7]);
        w1.x = pk2(v[8], v[9]); w1.y = pk2(v[10], v[11]); w1.z = pk2(v[12], v[13]); w1.w = pk2(v[14], v[15]);
        *(u32x4*)pp = w0; *(u32x4*)(pp + 8) = w1;
    }
}

__device__ __forceinline__ void phase_outproj(const Params& p, int l, LAS char* smem) {
    const int nrow = (l == 0) ? NROW : NLAT;
    pg8::Gemm g{(const bf16_t*)(p.ws + WS_S2) + (size_t)NROW * 1024, (const bf16_t*)(p.ws + WS_WOUT) + (size_t)l * 1024 * 1024, nrow, 1024, 1024, nullptr};
    pg8::StaticOrder S; S.init(nrow, 1024, gridDim.x, blockIdx.x);
    pg8::EpiOutY E{(bf16_t*)(p.ws + WS_S2)};
    pg8::gemm_phase((LAS unsigned char*)smem, g, S, E);
}

template <bool XBF>
__device__ __forceinline__ void phase_router_t(const Params& p, int l, LAS char* smem) {
    const int tid = otid(), lane = tid & 63, wave = tid >> 6;
    LAS float* rwT = (LAS float*)smem;
    for (int i = tid; i < 1024 * 16; i += NT) rwT[(i & 15) * 1024 + (i >> 4)] = p.router_w[(size_t)l * 1024 * 16 + i];
    const float* MODl = (const float*)(p.ws + WS_MOD) + (size_t)l * 17 * 6144;
    LAS float* modL = (LAS float*)(smem + 65536);
    const int nrow_ = (l == 0) ? NROW : NLAT;
    const int rpb_ = (nrow_ + gridDim.x - 1) / gridDim.x, rb_ = blockIdx.x * rpb_, re_ = max(min(rb_ + rpb_, nrow_) - 1, 0);
    const int bi0 = rb_ < NLAT ? (rb_ >> 11) : 16, bi1 = re_ < NLAT ? (re_ >> 11) : 16;
    for (int i = tid; i < 2 * 768; i += NT) { const int s = i >= 768, k = i - s * 768; *(LAS f32x4*)(modL + s * 3072 + 4 * k) = *(const f32x4*)(MODl + (s ? bi1 : bi0) * 6144 + 2048 + 4 * k); }
    __syncthreads();
    const float* g = p.norm2_g + l * 1024;
    bf16_t* HN = (bf16_t*)(p.ws + WS_S2);
    unsigned char* HN8 = (unsigned char*)(p.ws + WS_S2) + HN8_OFF;
    float* AFF = (float*)(p.ws + WS_AFF);
    const int nrow = (l == 0) ? NROW : NLAT;
    const void* xa = XBF ? (const void*)p.out : (const void*)p.x; const void* xb = XBF ? (const void*)(p.ws + WS_XC) : (const void*)p.ctx;
    f32x4 gg[4];
#pragma unroll
    for (int i = 0; i < 4; ++i) gg[i] = *(const f32x4*)(g + i * 256 + lane * 4);
    const int rpb = (nrow + gridDim.x - 1) / gridDim.x, rbeg = blockIdx.x * rpb, rend = min(rbeg + rpb, nrow);
    int r = rbeg + wave;
    XRaw<XBF> nx, nx2; u32x2 ny[4], ny2[4];
    if (r < rend) { xraw_load<XBF>(nx, xa, xb, r, lane); const bf16_t* ys = HN + (size_t)r * 1024 + lane * 4;
#pragma unroll
        for (int i = 0; i < 4; ++i) ny[i] = *(const u32x2*)(ys + i * 256); }
    if (r + 8 < rend) { const int r1 = r + 8; xraw_load<XBF>(nx2, xa, xb, r1, lane); const bf16_t* ys = HN + (size_t)r1 * 1024 + lane * 4;
#pragma unroll
        for (int i = 0; i < 4; ++i) ny2[i] = *(const u32x2*)(ys + i * 256); }
    int bic = -1; f32x4 g1v[4], shv[4], scv[4];
    auto body = [&](XRaw<XBF>& bx, u32x2 (&by)[4], const int r) {
        f32x4 v[4]; u32x2 yv[4];
        xraw_get<XBF>(bx, v);
#pragma unroll
        for (int i = 0; i < 4; ++i) yv[i] = by[i];
        { const int rn = min(r + 16, rend - 1);
          xraw_load<XBF>(bx, xa, xb, rn, lane); const bf16_t* ys = HN + (size_t)rn * 1024 + lane * 4;
#pragma unroll
          for (int i = 0; i < 4; ++i) by[i] = *(const u32x2*)(ys + i * 256); }
        const int bi = r < NLAT ? (r >> 11) : 16;
        if (bi != bic) { bic = bi;
#pragma unroll
            for (int i = 0; i < 4; ++i) { const LAS float* mb = modL + (bi == bi0 ? 0 : 3072) + i * 256 + lane * 4;
                g1v[i] = *(const LAS f32x4*)mb; shv[i] = *(const LAS f32x4*)(mb + 1024); scv[i] = *(const LAS f32x4*)(mb + 2048); } }
        {
            bf16_t* xo = (bf16_t*)(p.ws + WS_ZT) + (size_t)r * 1024 + lane * 4;
#pragma unroll
            for (int i = 0; i < 4; ++i) {
                const f32x4 g1 = g1v[i];
                v[i][0] += g1[0] * bflo(yv[i].x); v[i][1] += g1[1] * bfhi(yv[i].x); v[i][2] += g1[2] * bflo(yv[i].y); v[i][3] += g1[3] * bfhi(yv[i].y);
                u32x2 w; w.x = pk2(v[i][0], v[i][1]); w.y = pk2(v[i][2], v[i][3]);
                *(u32x2*)(xo + i * 256) = w;
            }
        }
        float ss = 0.f;
#pragma unroll
        for (int i = 0; i < 4; ++i) ss += v[i][0] * v[i][0] + v[i][1] * v[i][1] + v[i][2] * v[i][2] + v[i][3] * v[i][3];
        ss = wave_sum(ss);
        const float rstd = rsqrtf(ss * (1.f / 1024.f) + EPS);
#pragma unroll
        for (int i = 0; i < 4; ++i) {
            const int col = i * 256 + lane * 4;
            const f32x4 sh = shv[i], sc = scv[i];
#pragma unroll
            for (int j = 0; j < 4; ++j) v[i][j] = v[i][j] * rstd * gg[i][j] * (1.f + sc[j]) + sh[j];
            int q = 0; q = __builtin_amdgcn_cvt_pk_fp8_f32(v[i][0], v[i][1], q, false); q = __builtin_amdgcn_cvt_pk_fp8_f32(v[i][2], v[i][3], q, true);
            *(int*)(HN8 + (size_t)r * 1024 + col) = q;
        }
        float pe[16];
#pragma unroll
        for (int e2 = 0; e2 < 16; e2 += 2) {
            f32x4 w[2][4];
#pragma unroll
            for (int q = 0; q < 2; ++q)
#pragma unroll
                for (int i = 0; i < 4; ++i) w[q][i] = *(LAS f32x4*)(rwT + (e2 + q) * 1024 + i * 256 + lane * 4);
            __builtin_amdgcn_sched_barrier(0);
            hwf32x2_t s2[2][2];
#pragma unroll
            for (int q = 0; q < 2; ++q) { s2[q][0] = (hwf32x2_t){0.f, 0.f}; s2[q][1] = (hwf32x2_t){0.f, 0.f}; }
#pragma unroll
            for (int i = 0; i < 4; ++i)
#pragma unroll
                for (int q = 0; q < 2; ++q) {
                    s2[q][0] = __builtin_elementwise_fma((hwf32x2_t){v[i][0], v[i][1]}, (hwf32x2_t){w[q][i][0], w[q][i][1]}, s2[q][0]);
                    s2[q][1] = __builtin_elementwise_fma((hwf32x2_t){v[i][2], v[i][3]}, (hwf32x2_t){w[q][i][2], w[q][i][3]}, s2[q][1]);
                }
#pragma unroll
            for (int q = 0; q < 2; ++q) { const hwf32x2_t t = s2[q][0] + s2[q][1]; pe[e2 + q] = t[0] + t[1]; }
            __builtin_amdgcn_sched_barrier(0);
        }
        float q8[8], q4[4], q2[2], q1;
        { const bool hi = lane & 32;
#pragma unroll
          for (int i = 0; i < 8; ++i) { const float keep = hi ? pe[i + 8] : pe[i], send = hi ? pe[i] : pe[i + 8]; q8[i] = keep + __shfl_xor(send, 32); } }
        { const bool hi = lane & 16;
#pragma unroll
          for (int i = 0; i < 4; ++i) { const float keep = hi ? q8[i + 4] : q8[i], send = hi ? q8[i] : q8[i + 4]; q4[i] = keep + __shfl_xor(send, 16); } }
        { const bool hi = lane & 8;
#pragma unroll
          for (int i = 0; i < 2; ++i) { const float keep = hi ? q4[i + 2] : q4[i], send = hi ? q4[i] : q4[i + 2]; q2[i] = keep + __shfl_xor(send, 8); } }
        { const bool hi = lane & 4; const float keep = hi ? q2[1] : q2[0], send = hi ? q2[0] : q2[1]; q1 = keep + __shfl_xor(send, 4); }
        q1 += __shfl_xor(q1, 2); q1 += __shfl_xor(q1, 1);
        float mx = q1;
        mx = fmaxf(mx, __shfl_xor(mx, 4)); mx = fmaxf(mx, __shfl_xor(mx, 8)); mx = fmaxf(mx, __shfl_xor(mx, 16)); mx = fmaxf(mx, __shfl_xor(mx, 32));
        const float ex = expf(q1 - mx);
        float sum = ex;
        sum += __shfl_xor(sum, 4); sum += __shfl_xor(sum, 8); sum += __shfl_xor(sum, 16); sum += __shfl_xor(sum, 32);
        if ((lane & 3) == 0) AFF[(size_t)(lane >> 2) * NROW + r] = ex / sum;
    };
    for (; r + 8 < rend; r += 16) { body(nx, ny, r); body(nx2, ny2, r + 8); }
    if (r < rend) body(nx, ny, r);
    __syncthreads();
}

__device__ __forceinline__ void phase_router(const Params& p, int l, LAS char* smem) { if (l == 0) phase_router_t<false>(p, l, smem); else phase_router_t<true>(p, l, smem); }

__device__ __forceinline__ void phase_topk(const Params& p, int l, LAS char* smem) {
    const int tid = otid(), lane = tid & 63, wave = tid >> 6;
    LAS int* hist = (LAS int*)smem;
    LAS int* sc = hist + 768;
    const float* AFF = (const float*)(p.ws + WS_AFF);
    int* IDX = (int*)(p.ws + WS_IDX); float* GATE = (float*)(p.ws + WS_GATE); int* INV = (int*)(p.ws + WS_INV);
    const int nunits = (l == 0) ? 512 : 256;
    for (int u = blockIdx.x; u < nunits; u += gridDim.x) {
        int n, cap, r0, pos0; const int e = u & 15, b = (u >> 4) & 15;
        if (u < 256) { n = 2048; cap = CAPL; r0 = b * 2048; pos0 = b * CAPL; }
        else { n = 256; cap = CAPC; r0 = NLAT + b * 256; pos0 = NB * CAPL + b * CAPC; }
        const bool have = 4 * tid < n;
        f32x4 a = (f32x4){0.f, 0.f, 0.f, 0.f};
        if (have) a = *(const f32x4*)(AFF + (size_t)e * NROW + r0 + 4 * tid);
        const unsigned uu[4] = {__float_as_uint(a[0]), __float_as_uint(a[1]), __float_as_uint(a[2]), __float_as_uint(a[3])};
        hist[tid] = 0; if (tid < 256) hist[512 + tid] = 0;
        __syncthreads();
        unsigned prefix = 0u; int remaining = cap;
#pragma unroll
        for (int pass = 0; pass < 4; ++pass) {
            const int shift = 24 - 8 * pass;
            LAS int* H = hist + (pass % 3) * 256;
            const unsigned hmask = pass == 0 ? 0u : (0xFFFFFFFFu << (shift + 8));
#pragma unroll
            for (int i = 0; i < 4; ++i)
                if (have && ((uu[i] & hmask) == prefix)) __hip_atomic_fetch_add(H + ((uu[i] >> shift) & 255u), 1, __ATOMIC_RELAXED, __HIP_MEMORY_SCOPE_WORKGROUP);
            if (pass == 2 && tid < 256) hist[tid] = 0;
            __syncthreads();
            const LAS int* hp = H + 4 * lane;
            const int h0 = hp[0], h1 = hp[1], h2 = hp[2], h3 = hp[3];
            const int t = h0 + h1 + h2 + h3;
            int suf = t;
#pragma unroll
            for (int o = 1; o < 64; o <<= 1) { const int v = __shfl_down(suf, o); if (lane + o < 64) suf += v; }
            const int a3 = suf - t, a2 = a3 + h3, a1 = a2 + h2, a0 = a1 + h1;
            const bool has = a3 < remaining && remaining <= suf;
            int dg, nr;
            if (remaining <= a2) { dg = 3; nr = remaining - a3; } else if (remaining <= a1) { dg = 2; nr = remaining - a2; } else if (remaining <= a0) { dg = 1; nr = remaining - a1; } else { dg = 0; nr = remaining - a0; }
            const unsigned long long bm = __ballot(has);
            const int src = __ffsll((long long)bm) - 1;
            const int digit = __shfl(4 * lane + dg, src);
            remaining = __shfl(nr, src);
            prefix |= (unsigned)digit << shift;
        }
        const unsigned T = prefix; const int cgt = cap - remaining;
        int cg = 0, ce = 0;
#pragma unroll
        for (int i = 0; i < 4; ++i) { cg += (have && uu[i] > T) ? 1 : 0; ce += (have && uu[i] == T) ? 1 : 0; }
        const int packed = cg | (ce << 16);
        int incl = packed;
#pragma unroll
        for (int o = 1; o < 64; o <<= 1) { const int v = __shfl_up(incl, o); if (lane >= o) incl += v; }
        if (lane == 63) sc[16 + wave] = incl;
        __syncthreads();
        int woff = 0;
#pragma unroll
        for (int w = 0; w < 8; ++w) woff += (w < wave) ? sc[16 + w] : 0;
        const int excl = woff + incl - packed;
        int bg = excl & 0xffff, be = excl >> 16;
        if (have) {
            int sl[4];
#pragma unroll
            for (int i = 0; i < 4; ++i) {
                const int r = r0 + 4 * tid + i; int slot = -1;
                if (uu[i] > T) slot = bg++;
                else if (uu[i] == T) { const int s2 = cgt + be++; if (s2 < cap) slot = s2; }
                if (slot >= 0) { IDX[e * MEST + pos0 + slot] = r; GATE[e * MEST + pos0 + slot] = a[i]; }
                sl[i] = slot >= 0 ? pos0 + slot : -1;
            }
            *(int4*)(INV + (size_t)e * NROW + r0 + 4 * tid) = make_int4(sl[0], sl[1], sl[2], sl[3]);
        }
        __syncthreads();
    }
}

__device__ __forceinline__ void phase_gather(const Params& p, int l) {
    const int tid = otid(), lane = tid & 63, wave = tid >> 6;
    const unsigned char* HN8 = (const unsigned char*)(p.ws + WS_S2) + HN8_OFF;
    unsigned char* XG8 = (unsigned char*)(p.ws + WS_S1) + XG8_OFF;
    const int* IDX = (const int*)(p.ws + WS_IDX);
    const int me = (l == 0) ? MEST : NB * CAPL;
    for (int g0 = (blockIdx.x * 8 + wave) * 4; g0 < NE * me; g0 += gridDim.x * 32) {
        const int e = g0 / me, pos = g0 % me;
        int rr[4];
#pragma unroll
        for (int i = 0; i < 4; ++i) rr[i] = IDX[e * MEST + pos + i];
        u32x4 a[4];
#pragma unroll
        for (int i = 0; i < 4; ++i) a[i] = *(const u32x4*)(HN8 + (size_t)rr[i] * 1024 + lane * 16);
#pragma unroll
        for (int i = 0; i < 4; ++i) *(u32x4*)(XG8 + ((size_t)e * MEST + pos + i) * 1024 + lane * 16) = a[i];
    }
}

__device__ __forceinline__ void phase_gemm1(const Params& p, int l, LAS char* smem) {
    pg8::Gemm g{(const bf16_t*)(p.ws + WS_S2 + HN8_OFF), (const bf16_t*)(p.ws + WS_WGU), NE * MEST, NE * 2048, 1024, (const int*)(p.ws + WS_IDX)};
    pg8::ExpertOrder S{(l == 0) ? MEST / 256 : (NB * CAPL) / 256, 8, (int)gridDim.x, (int)blockIdx.x};
    pg8::EpiSwiglu E{(unsigned char*)(p.ws + WS_S1)};
    pg8::gemm_phase<pg8::EpiSwiglu, pg8::ExpertOrder, true, true, 122, 127>((LAS unsigned char*)smem, g, S, E);
}
__device__ __forceinline__ void phase_gemm2(const Params& p, int l, LAS char* smem) {
    pg8::Gemm g{(const bf16_t*)(p.ws + WS_S1), (const bf16_t*)(p.ws + WS_WD), NE * MEST, NE * 1024, 1024, nullptr};
    pg8::ExpertOrder S{(l == 0) ? MEST / 256 : (NB * CAPL) / 256, 4, (int)gridDim.x, (int)blockIdx.x};
    pg8::EpiDown E{(unsigned char*)(p.ws + WS_S2)};
    pg8::gemm_phase<pg8::EpiDown, pg8::ExpertOrder, false, true, 122, 125>((LAS unsigned char*)smem, g, S, E);
}

__device__ __forceinline__ void phase_combine(const Params& p, int l, LAS char* smem) {
    const int tid = otid(), lane = tid & 63, wave = tid >> 6;
    const unsigned char* O = (const unsigned char*)(p.ws + WS_S2); const int* INV = (const int*)(p.ws + WS_INV); const float* GATE = (const float*)(p.ws + WS_GATE);
    const float* MODl = (const float*)(p.ws + WS_MOD) + (size_t)l * 17 * 6144;
    const int nrow = (l == 0) ? NROW : NLAT;
    float* xl0 = p.out; float* xl1 = (float*)(p.ws + WS_XC);
    const int rpb = (nrow + gridDim.x - 1) / gridDim.x, rbeg = blockIdx.x * rpb, rend = min(rbeg + rpb, nrow);
    const bf16_t* X1B = (const bf16_t*)(p.ws + WS_ZT);
    LAS int* linv = (LAS int*)smem;
    LAS float* modL = (LAS float*)(smem + 32768);
    const int re_ = max(rend - 1, 0), bi0 = rbeg < NLAT ? (rbeg >> 11) : 16, bi1 = re_ < NLAT ? (re_ >> 11) : 16;
    __syncthreads();
    for (int i = tid; i < 16 * rpb; i += NT) { const int e = i / rpb, k = i - e * rpb; linv[k * 16 + e] = (rbeg + k < rend) ? INV[(size_t)e * NROW + rbeg + k] : -1; }
    for (int i = tid; i < 2 * 256; i += NT) { const int s = i >= 256, k = i - s * 256; *(LAS f32x4*)(modL + s * 1024 + 4 * k) = *(const f32x4*)(MODl + (s ? bi1 : bi0) * 6144 + 5120 + 4 * k); }
    __syncthreads();
    if (rbeg >= rend) return;
    struct RowBuf { u32x4 xa, xb, ea[4]; float gt[4], gm[4]; };
    auto fetch = [&](RowBuf& B, const int rr) {
        const int r = min(rr, rend - 1);
        const bf16_t* xr = X1B + (size_t)r * 1024 + lane * 16; B.xa = *(const u32x4*)xr; B.xb = *(const u32x4*)(xr + 8);
        const int inv = linv[(r - rbeg) * 16 + (lane & 15)];
        unsigned mask = (unsigned)(__ballot(inv >= 0) & 0xffffull);
#pragma unroll
        for (int j = 0; j < 4; ++j) {
            const int e = mask ? __builtin_ctz(mask) : 0; const bool on = mask != 0; mask &= mask - 1;
            const int pos = on ? __shfl(inv, e) : 0;
            B.gt[j] = GATE[e * MEST + pos]; B.gm[j] = on ? (1.f / pg8::O_SCALE) : 0.f;
            B.ea[j] = *(const u32x4*)(O + ((size_t)e * MEST + pos) * 1024 + lane * 16);
        }
    };
    int bic = -1; f32x4 g2v[4];
    auto body = [&](RowBuf& B, const int r) {
        float acc[16];
#pragma unroll
        for (int i = 0; i < 16; ++i) acc[i] = 0.f;
#pragma unroll
        for (int j = 0; j < 4; ++j) { const float gt = B.gt[j] * B.gm[j];
#pragma unroll
            for (int wq = 0; wq < 4; ++wq) { const int w = (int)B.ea[j][wq];
                acc[wq * 4 + 0] += gt * __builtin_amdgcn_cvt_f32_fp8(w, 0); acc[wq * 4 + 1] += gt * __builtin_amdgcn_cvt_f32_fp8(w, 1);
                acc[wq * 4 + 2] += gt * __builtin_amdgcn_cvt_f32_fp8(w, 2); acc[wq * 4 + 3] += gt * __builtin_amdgcn_cvt_f32_fp8(w, 3); } }
        const u32x4 xa_ = B.xa, xb_ = B.xb;
        const int inv = linv[(r - rbeg) * 16 + (lane & 15)];
        unsigned long long mask = __ballot(inv >= 0) & 0xffffull;
        fetch(B, r + 16);
        if (__builtin_popcountll(mask) > 4) {
            mask &= mask - 1; mask &= mask - 1; mask &= mask - 1; mask &= mask - 1;
            while (mask) {
                const int e = __builtin_ctzll(mask); mask &= mask - 1;
                const int pos = __shfl(inv, e);
                const float gt = GATE[e * MEST + pos] * (1.f / pg8::O_SCALE);
                const u32x4 a = *(const u32x4*)(O + ((size_t)e * MEST + pos) * 1024 + lane * 16);
#pragma unroll
                for (int wq = 0; wq < 4; ++wq) { const int w = (int)a[wq];
                    acc[wq * 4 + 0] += gt * __builtin_amdgcn_cvt_f32_fp8(w, 0); acc[wq * 4 + 1] += gt * __builtin_amdgcn_cvt_f32_fp8(w, 1);
                    acc[wq * 4 + 2] += gt * __builtin_amdgcn_cvt_f32_fp8(w, 2); acc[wq * 4 + 3] += gt * __builtin_amdgcn_cvt_f32_fp8(w, 3); }
            }
        }
        const int bi = r < NLAT ? (r >> 11) : 16;
        if (bi != bic) { bic = bi;
#pragma unroll
            for (int q4 = 0; q4 < 4; ++q4) g2v[q4] = *(const LAS f32x4*)(modL + (bi == bi0 ? 0 : 1024) + lane * 16 + q4 * 4); }
        const float x1v[16] = {bflo(xa_.x), bfhi(xa_.x), bflo(xa_.y), bfhi(xa_.y), bflo(xa_.z), bfhi(xa_.z), bflo(xa_.w), bfhi(xa_.w),
                               bflo(xb_.x), bfhi(xb_.x), bflo(xb_.y), bfhi(xb_.y), bflo(xb_.z), bfhi(xb_.z), bflo(xb_.w), bfhi(xb_.w)};
        f32x4 o4[4];
#pragma unroll
        for (int q4 = 0; q4 < 4; ++q4) {
            const f32x4 gv = g2v[q4];
#pragma unroll
            for (int j = 0; j < 4; ++j) o4[q4][j] = x1v[q4 * 4 + j] + gv[j] * acc[q4 * 4 + j];
        }
        if (l == 0) {
            bf16_t* xr = (r < NLAT ? (bf16_t*)xl0 + (size_t)r * D : (bf16_t*)xl1 + (size_t)(r - NLAT) * D) + lane * 16;
            u32x4 wa, wb;
            wa.x = pk2(o4[0][0], o4[0][1]); wa.y = pk2(o4[0][2], o4[0][3]); wa.z = pk2(o4[1][0], o4[1][1]); wa.w = pk2(o4[1][2], o4[1][3]);
            wb.x = pk2(o4[2][0], o4[2][1]); wb.y = pk2(o4[2][2], o4[2][3]); wb.z = pk2(o4[3][0], o4[3][1]); wb.w = pk2(o4[3][2], o4[3][3]);
            *(u32x4*)xr = wa; *(u32x4*)(xr + 8) = wb;
        } else {
            float* xr = xl0 + (size_t)r * D + lane * 16;
            *(f32x4*)xr = o4[0]; *(f32x4*)(xr + 4) = o4[1]; *(f32x4*)(xr + 8) = o4[2]; *(f32x4*)(xr + 12) = o4[3];
        }
    };
    RowBuf A, B;
    int r = rbeg + wave;
    fetch(A, r); fetch(B, r + 8);
    for (; r + 8 < rend; r += 16) { body(A, r); body(B, r + 8); }
    if (r < rend) body(A, r);
}

constexpr int PH_PER_LAYER = 12, N_PHASES = 1 + 2 * PH_PER_LAYER;
constexpr int WX_JOBS = 48 * 128, WX_TAIL_IN = 96 * 8, WX_TAIL_OUT = 192 * 8, WX_TAIL_G2 = 128 * 8;
__device__ __forceinline__ int wx_first_job(int l, int G) { return (l == 1 && G == 256) ? WX_TAIL_G2 : 0; }
__device__ __forceinline__ int wx_main_jobs(int l) { return WX_JOBS - WX_TAIL_IN - (l == 0 ? WX_TAIL_OUT : 0); }
__global__ void __launch_bounds__(NT) mega(Params p) {
    extern __shared__ __attribute__((aligned(16))) unsigned char lds_raw[];
    LAS char* smem = (LAS char*)lds_raw;
#if MK_ONE_LAUNCH
    volatile LAS unsigned* st = (volatile LAS unsigned*)(smem + LDS_BYTES - 16);
    if (threadIdx.x == 0) { st[0] = 0u; st[1] = 0u; }
    __syncthreads();
    XcdBarrier bar = xcd_barrier_post((unsigned*)(p.ws + WS_CTL) + 4096, st);
#endif
    for (int ph = p.ph_lo; ph < p.ph_hi; ++ph) {
#if REP_MASK
        const int s_ = ph == 0 ? 12 : (ph - 1) % PH_PER_LAYER;
        const int reps = ((REP_MASK >> s_) & 1) ? 2 : 1;
        for (int rep = 0; rep < reps; ++rep) {
        if (rep) xcd_barrier(bar);
#endif
        if (ph == 0) phase_prep(p, smem);
        else {
            const int l = (ph - 1) / PH_PER_LAYER, s = (ph - 1) % PH_PER_LAYER;
            switch (s) {
                case 0: phase_wexp(p, l, smem, wx_first_job(l, gridDim.x), wx_main_jobs(l), 0, gridDim.x); phase_norm1(p, l, smem); break;
                case 1: phase_inproj(p, l, smem); if (gridDim.x == 256) phase_wexp(p, l, smem, wx_main_jobs(l), wx_main_jobs(l) + WX_TAIL_IN, 160, 96); else phase_wexp(p, l, smem, wx_main_jobs(l), wx_main_jobs(l) + WX_TAIL_IN, 0, gridDim.x); break;
                case 2: break;
                case 3: phase_mix(p, l, smem); break;
                case 4: break;
                case 5: phase_outproj(p, l, smem); if (l == 0) { if (gridDim.x == 256) phase_wexp(p, l, smem, WX_JOBS - WX_TAIL_OUT, WX_JOBS, 64, 192); else phase_wexp(p, l, smem, WX_JOBS - WX_TAIL_OUT, WX_JOBS, 0, gridDim.x); } break;
                case 6: phase_router(p, l, smem); break;
                case 7: phase_topk(p, l, smem); break;
                case 8: break;
                case 9: phase_gemm1(p, l, smem); break;
                case 10: phase_gemm2(p, l, smem); if (l == 0 && gridDim.x == 256) phase_wexp(p, 1, smem, 0, WX_TAIL_G2, 128, 128); break;
                default: phase_combine(p, l, smem); break;
            }
        }
#if REP_MASK
        }
#endif
#if MK_ONE_LAUNCH
        if (ph + 1 < p.ph_hi && !(ph > 0 && ((ph - 1) % PH_PER_LAYER == 4 || (ph - 1) % PH_PER_LAYER == 2 || (ph - 1) % PH_PER_LAYER == 8))) xcd_barrier(bar);
#endif
    }
}

extern "C" void kernel_launch(void* const* d_in, const int* in_sizes, int n_in, void* d_out, int out_size, void* d_ws, size_t ws_size, hipStream_t stream) {
    static int grid = 0;
    if (grid == 0) {
        if (n_in != 23 || ws_size < WS_END) { fprintf(stderr, "kernel_launch: unexpected n_in %d / ws_size %zu\n", n_in, ws_size); grid = -1; return; }
        int dev = 0, cus = 0, per_cu = 0;
        if (hipGetDevice(&dev) != hipSuccess || hipDeviceGetAttribute(&cus, hipDeviceAttributeMultiprocessorCount, dev) != hipSuccess) { grid = -1; return; }
        if (hipFuncSetAttribute((const void*)mega, hipFuncAttributeMaxDynamicSharedMemorySize, LDS_BYTES) != hipSuccess) { fprintf(stderr, "kernel_launch: hipFuncSetAttribute failed\n"); grid = -1; return; }
        if (hipOccupancyMaxActiveBlocksPerMultiprocessor(&per_cu, (const void*)mega, NT, LDS_BYTES) != hipSuccess || per_cu < 1) { fprintf(stderr, "kernel_launch: occupancy query says %d blocks/CU\n", per_cu); per_cu = 1; }
        (void)hipGetLastError();
        grid = cus;
        if (grid < 32) { fprintf(stderr, "kernel_launch: the row passes need at least 32 workgroups (a block's rows must lie in at most two batches)\n"); grid = -1; return; }
    }
    if (grid < 0) return;
    Params p{};
    const float** pp = (const float**)&p;
    for (int i = 0; i < 23; ++i) pp[i] = (const float*)d_in[i];
    p.out = (float*)d_out; p.ws = (unsigned char*)d_ws;
#if MK_ONE_LAUNCH
    (void)hipMemsetAsync((char*)d_ws + WS_CTL, 0, CTL_BYTES, stream);
    p.ph_lo = 0; p.ph_hi = N_PHASES;
    hipLaunchKernelGGL(mega, dim3(grid), dim3(NT), LDS_BYTES, stream, p);
#else
    for (int ph = 0; ph < N_PHASES; ++ph) {
        p.ph_lo = ph; p.ph_hi = ph + 1;
        hipLaunchKernelGGL(mega, dim3(grid), dim3(NT), LDS_BYTES, stream, p);
    }
#endif
}
```
